# Optimizing an MI355X kernel written in HIP

```python
import jax, jax.numpy as jnp
from jax import lax
import numpy as np

D_MODEL = 1024
BATCH = 2
SEQ = 16384
DEPTH = 2

HEAD_DIM = 64
FOX_HEADS = 8
NSA_HEADS = 8
NSA_KV_GROUPS = 2
NSA_GROUP_SIZE = NSA_HEADS // NSA_KV_GROUPS
CMP_BLOCK = 32
CMP_STRIDE = 16
SLC_BLOCK = 64
N_SELECT = 16
WINDOW = 512
Q_BLOCK = 128
POOL_WINDOWS = (2, 4, 8, 16)
POOL_GROUP = D_MODEL // len(POOL_WINDOWS)
FFN_HIDDEN = -(-8 * D_MODEL // (3 * 256)) * 256
RMS_EPS = 1e-6
NEG_INF = -1e30
BIG = 1e30
N_EVEN = (DEPTH + 1) // 2
N_ODD = DEPTH // 2
MIX_WIDTH = (FOX_HEADS + NSA_HEADS) * HEAD_DIM
KV_DIM = NSA_KV_GROUPS * HEAD_DIM
IN_SIZES = (FOX_HEADS * HEAD_DIM, FOX_HEADS * HEAD_DIM, FOX_HEADS * HEAD_DIM, FOX_HEADS,
            NSA_HEADS * HEAD_DIM, KV_DIM, KV_DIM, KV_DIM, KV_DIM, KV_DIM, KV_DIM, 3 * NSA_HEADS)
IN_COLS = sum(IN_SIZES)

kernel_name = "fox_nsa_pool_hybrid_trunk"


def rmsnorm(x, g):
    xf = x.astype(jnp.float32)
    y = xf * lax.rsqrt(jnp.mean(xf * xf, axis=-1, keepdims=True) + RMS_EPS)
    return (y * g.astype(jnp.float32)).astype(x.dtype)


def masked_softmax(s, mask):
    s = jnp.where(mask, s, NEG_INF)
    m = jnp.max(s, axis=-1, keepdims=True)
    e = jnp.where(mask, jnp.exp(s - m), 0.0)
    return e / jnp.maximum(jnp.sum(e, axis=-1, keepdims=True), 1e-30)


def alibi_slopes(n):
    return jnp.asarray(2.0 ** (-8.0 * (np.arange(n, dtype=np.float32) + 1.0) / n), dtype=jnp.float32)


def fox_attention(q, k, v, log_f):
    B, S, H, dh = q.shape
    c = jnp.transpose(jnp.cumsum(log_f, axis=1), (0, 2, 1))
    kpos = jnp.arange(S)
    scale = dh ** -0.5

    def block(qb):
        start = qb * Q_BLOCK
        t = start + jnp.arange(Q_BLOCK)
        qi = lax.dynamic_slice_in_dim(q, start, Q_BLOCK, axis=1)
        ci = lax.dynamic_slice_in_dim(c, start, Q_BLOCK, axis=2)
        s = jnp.einsum('bqhd,bkhd->bhqk', qi, k).astype(jnp.float32) * scale
        s = s + ci[..., None] - c[:, :, None, :]
        mask = kpos[None, :] <= t[:, None]
        p = masked_softmax(s, mask)
        return jnp.einsum('bhqk,bkhd->bqhd', p.astype(v.dtype), v)

    out = lax.map(block, jnp.arange(S // Q_BLOCK))
    return jnp.transpose(out, (1, 0, 2, 3, 4)).reshape(B, S, H * dh)


def nsa_compress(tok, pe, w1, w2):
    B, S, G, dh = tok.shape
    r = CMP_BLOCK // CMP_STRIDE
    n_chunks = S // CMP_STRIDE
    n_c = n_chunks - r + 1
    chunks = tok.reshape(B, n_chunks, CMP_STRIDE, G, dh)
    blocks = jnp.concatenate([chunks[:, j:j + n_c] for j in range(r)], axis=2)
    blocks = blocks + pe[None, None, :, None, :]
    flat = jnp.transpose(blocks, (0, 1, 3, 2, 4)).reshape(B, n_c, G, CMP_BLOCK * dh)
    return jax.nn.gelu(flat @ w1) @ w2


def nsa_attention(q, k_c, v_c, k_s, v_s, k_w, v_w, gates, pe, w1, w2):
    B, S, H, dh = q.shape
    G = k_c.shape[2]
    R = H // G
    scale = dh ** -0.5
    slopes = alibi_slopes(H).reshape(G, R)
    dt = q.dtype
    r = CMP_BLOCK // CMP_STRIDE
    ratio = SLC_BLOCK // CMP_STRIDE
    n_s = S // SLC_BLOCK
    n_sel = min(N_SELECT, n_s)

    kc = nsa_compress(k_c, pe[0], w1[0], w2[0])
    vc = nsa_compress(v_c, pe[1], w1[1], w2[1])
    n_c = kc.shape[1]
    cmp_end = jnp.arange(n_c) * CMP_STRIDE + CMP_BLOCK - 1

    q_g = q.reshape(B, S, G, R, dh)
    k_blocks = jnp.transpose(k_s.reshape(B, n_s, SLC_BLOCK, G, dh), (0, 3, 1, 2, 4)).reshape(B, G, n_s, SLC_BLOCK * dh)
    v_blocks = jnp.transpose(v_s.reshape(B, n_s, SLC_BLOCK, G, dh), (0, 3, 1, 2, 4)).reshape(B, G, n_s, SLC_BLOCK * dh)
    k_w_pad = jnp.pad(k_w, ((0, 0), (WINDOW, 0), (0, 0), (0, 0)))
    v_w_pad = jnp.pad(v_w, ((0, 0), (WINDOW, 0), (0, 0), (0, 0)))
    blk = jnp.arange(n_s)

    def block(qb):
        start = qb * Q_BLOCK
        t = start + jnp.arange(Q_BLOCK)
        tf = t.astype(jnp.float32)
        qi = lax.dynamic_slice_in_dim(q_g, start, Q_BLOCK, axis=1)
        gi = lax.dynamic_slice_in_dim(gates, start, Q_BLOCK, axis=1)

        d_c = tf[:, None] - cmp_end[None, :].astype(jnp.float32)
        s_c = jnp.einsum('bqgrd,bngd->bgrqn', qi, kc).astype(jnp.float32) * scale
        s_c = s_c - slopes[None, :, :, None, None] * d_c
        p_c = masked_softmax(s_c, d_c >= 0)
        o_c = jnp.einsum('bgrqn,bngd->bqgrd', p_c.astype(dt), vc)

        imp = jnp.sum(p_c, axis=2)
        imp = jnp.pad(imp, ((0, 0), (0, 0), (0, 0), (r - 1, ratio * n_s + r - 1 - n_c - (r - 1))))
        p_slc = imp[..., 0:ratio * n_s:ratio]
        for o in range(1, ratio + r - 1):
            p_slc = p_slc + imp[..., o:o + ratio * n_s:ratio]
        cur = t // SLC_BLOCK
        forced = (blk[None, :] == 0) | (blk[None, :] == cur[:, None]) | (blk[None, :] == cur[:, None] - 1)
        future = blk[None, :] > cur[:, None]
        p_slc = jnp.where(forced, BIG, jnp.where(future, NEG_INF, p_slc))
        _, idx = lax.top_k(p_slc, n_sel)

        flat_idx = idx.reshape(B, G, Q_BLOCK * n_sel)[..., None]
        kg = jnp.take_along_axis(k_blocks, flat_idx, axis=2).reshape(B, G, Q_BLOCK, n_sel * SLC_BLOCK, dh)
        vg = jnp.take_along_axis(v_blocks, flat_idx, axis=2).reshape(B, G, Q_BLOCK, n_sel * SLC_BLOCK, dh)
        kpos = (idx[..., None] * SLC_BLOCK + jnp.arange(SLC_BLOCK)).reshape(B, G, Q_BLOCK, n_sel * SLC_BLOCK)
        d_s = (t[None, None, :, None] - kpos).astype(jnp.float32)
        s_s = jnp.einsum('bqgrd,bgqkd->bgrqk', qi, kg).astype(jnp.float32) * scale
        s_s = s_s - slopes[None, :, :, None, None] * d_s[:, :, None]
        p_s = masked_softmax(s_s, (d_s >= 0)[:, :, None])
        o_s = jnp.einsum('bgrqk,bgqkd->bqgrd', p_s.astype(dt), vg)

        kw = lax.dynamic_slice_in_dim(k_w_pad, start, WINDOW + Q_BLOCK, axis=1)
        vw = lax.dynamic_slice_in_dim(v_w_pad, start, WINDOW + Q_BLOCK, axis=1)
        wpos = start - WINDOW + jnp.arange(WINDOW + Q_BLOCK)
        d_w = t[:, None] - wpos[None, :]
        m_w = (d_w >= 0) & (d_w < WINDOW) & (wpos[None, :] >= 0)
        s_w = jnp.einsum('bqgrd,bkgd->bgrqk', qi, kw).astype(jnp.float32) * scale
        s_w = s_w - slopes[None, :, :, None, None] * d_w.astype(jnp.float32)
        p_w = masked_softmax(s_w, m_w)
        o_w = jnp.einsum('bgrqk,bkgd->bqgrd', p_w.astype(dt), vw)

        return gi[..., 0:1] * o_c + gi[..., 1:2] * o_s + gi[..., 2:3] * o_w

    out = lax.map(block, jnp.arange(S // Q_BLOCK))
    return jnp.transpose(out, (1, 0, 2, 3, 4, 5)).reshape(B, S, H * dh)


def mixer_fox_nsa(h, w_in, b_f, cmp_pe, cmp_w1, cmp_w2, w_out):
    B, S, _ = h.shape
    proj = h @ w_in
    offs = [0]
    for n in IN_SIZES:
        offs.append(offs[-1] + n)
    fq, fk, fv, ff, nq, kc, vc, ks, vs, kw, vw, ng = [proj[..., offs[i]:offs[i + 1]] for i in range(len(IN_SIZES))]
    hd = (B, S, FOX_HEADS, HEAD_DIM)
    log_f = jax.nn.log_sigmoid((ff + b_f).astype(jnp.float32))
    o_fox = fox_attention(fq.reshape(hd), fk.reshape(hd), fv.reshape(hd), log_f)
    kvd = (B, S, NSA_KV_GROUPS, HEAD_DIM)
    gates = jax.nn.sigmoid(ng.astype(jnp.float32)).astype(h.dtype).reshape(B, S, NSA_KV_GROUPS, NSA_GROUP_SIZE, 3)
    o_nsa = nsa_attention(nq.reshape(B, S, NSA_HEADS, HEAD_DIM), kc.reshape(kvd), vc.reshape(kvd),
                          ks.reshape(kvd), vs.reshape(kvd), kw.reshape(kvd), vw.reshape(kvd),
                          gates, cmp_pe, cmp_w1, cmp_w2)
    return jnp.concatenate([o_fox, o_nsa], axis=-1) @ w_out


def mixer_pool(h, w_groups, scale):
    B, S, D = h.shape
    hf = h.astype(jnp.float32)
    c = jnp.cumsum(hf, axis=1)
    count = jnp.arange(1, S + 1, dtype=jnp.float32)
    outs = []
    for gi, w in enumerate(POOL_WINDOWS):
        sl = slice(gi * POOL_GROUP, (gi + 1) * POOL_GROUP)
        cg = c[..., sl]
        lag = jnp.pad(cg, ((0, 0), (w, 0), (0, 0)))[:, :S]
        mean = (cg - lag) / jnp.minimum(count, float(w))[None, :, None]
        outs.append(mean - hf[..., sl])
    pooled = jnp.stack(outs, axis=2).astype(h.dtype)
    y = jnp.einsum('bsgc,gcd->bsgd', pooled, w_groups).reshape(B, S, D)
    return y * scale


def swiglu(h, w_gate, w_up, w_down):
    return (jax.nn.silu(h @ w_gate) * (h @ w_up)) @ w_down


def setup_inputs(seed: int = 0) -> dict:
    key = jax.random.key(seed)
    ks = jax.random.split(key, 13)
    f32 = jnp.float32
    dh = HEAD_DIM
    x = jax.random.normal(ks[0], (BATCH, SEQ, D_MODEL), f32)
    norm_g = 1.0 + 0.05 * jax.random.normal(ks[1], (DEPTH, 4, D_MODEL), f32)
    attn_w_in = jax.random.normal(ks[2], (N_EVEN, D_MODEL, IN_COLS), f32) * D_MODEL ** -0.5
    fox_b_f = jax.random.uniform(ks[3], (N_EVEN, FOX_HEADS), f32, 1.0, 4.0)
    nsa_cmp_pe = 0.1 * jax.random.normal(ks[4], (N_EVEN, 2, CMP_BLOCK, dh), f32)
    nsa_cmp_w1 = jax.random.normal(ks[5], (N_EVEN, 2, CMP_BLOCK * dh, dh), f32) * (CMP_BLOCK * dh) ** -0.5
    nsa_cmp_w2 = jax.random.normal(ks[6], (N_EVEN, 2, dh, dh), f32) * dh ** -0.5
    attn_w_out = jax.random.normal(ks[7], (N_EVEN, MIX_WIDTH, D_MODEL), f32) * MIX_WIDTH ** -0.5
    pool_w = jax.random.normal(ks[8], (N_ODD, len(POOL_WINDOWS), POOL_GROUP, POOL_GROUP), f32) * POOL_GROUP ** -0.5
    pool_scale = 1.0 + 0.1 * jax.random.normal(ks[9], (N_ODD, D_MODEL), f32)
    ffn_w_gate = jax.random.normal(ks[10], (DEPTH, D_MODEL, FFN_HIDDEN), f32) * D_MODEL ** -0.5
    ffn_w_up = jax.random.normal(ks[11], (DEPTH, D_MODEL, FFN_HIDDEN), f32) * D_MODEL ** -0.5
    ffn_w_down = jax.random.normal(ks[12], (DEPTH, FFN_HIDDEN, D_MODEL), f32) * FFN_HIDDEN ** -0.5
    return {"x": x, "norm_g": norm_g, "attn_w_in": attn_w_in, "fox_b_f": fox_b_f,
            "nsa_cmp_pe": nsa_cmp_pe, "nsa_cmp_w1": nsa_cmp_w1, "nsa_cmp_w2": nsa_cmp_w2,
            "attn_w_out": attn_w_out, "pool_w": pool_w, "pool_scale": pool_scale,
            "ffn_w_gate": ffn_w_gate, "ffn_w_up": ffn_w_up, "ffn_w_down": ffn_w_down}


def reference(x, norm_g, attn_w_in, fox_b_f, nsa_cmp_pe, nsa_cmp_w1, nsa_cmp_w2, attn_w_out,
              pool_w, pool_scale, ffn_w_gate, ffn_w_up, ffn_w_down):
    h = x
    for layer in range(DEPTH):
        g = norm_g[layer]
        i = layer // 2
        u = rmsnorm(h, g[0])
        if layer % 2 == 0:
            m = mixer_fox_nsa(u, attn_w_in[i], fox_b_f[i], nsa_cmp_pe[i], nsa_cmp_w1[i], nsa_cmp_w2[i], attn_w_out[i])
        else:
            m = mixer_pool(u, pool_w[i], pool_scale[i])
        h = h + rmsnorm(m, g[1])
        u = rmsnorm(h, g[2])
        h = h + rmsnorm(swiglu(u, ffn_w_gate[layer], ffn_w_up[layer], ffn_w_down[layer]), g[3])
    return h
```

```cpp
#include <hip/hip_runtime.h>
#include <hip/hip_cooperative_groups.h>
#include <cstdio>
#include <cstdint>
namespace cg = cooperative_groups;
#ifndef PROBE_SUB
#define PROBE_SUB 0
#endif

#define DI __device__ __forceinline__
#define LAS __attribute__((address_space(3)))
typedef LAS char* lptr;
typedef unsigned short bf16_t;
typedef short bf16x8 __attribute__((ext_vector_type(8)));
typedef float f32x4 __attribute__((ext_vector_type(4)));
typedef float f32x2 __attribute__((ext_vector_type(2)));
typedef float f32x16 __attribute__((ext_vector_type(16)));
typedef unsigned u32x4 __attribute__((ext_vector_type(4)));
typedef unsigned u32x2 __attribute__((ext_vector_type(2)));
typedef __bf16 bf16x2_t __attribute__((ext_vector_type(2)));

DI unsigned pk_bf16(float lo, float hi) { f32x2 v = {lo, hi}; bf16x2_t b = __builtin_convertvector(v, bf16x2_t); return __builtin_bit_cast(unsigned, b); }
DI float bf2f(bf16_t v) { return __uint_as_float(((unsigned)v) << 16); }
DI float bflo(unsigned w) { return __uint_as_float(w << 16); }
DI float bfhi(unsigned w) { return __uint_as_float(w & 0xffff0000u); }

namespace pg8 {
#define PG8_LAS __attribute__((address_space(3)))
constexpr int BM = 256, BK = 64, HALF = 128, HTB = HALF * BK * 2, STAGE_BYTES = 8 * HTB, NXCD = 8, WGM = 8;
__host__ __device__ __forceinline__ int lds_byte(int r, int c) { const int st = (r >> 4) * 2 + (c >> 5), rr = r & 15, cc = c & 31, ob = rr * 64 + cc * 2; return st * 1024 + (ob ^ (((ob >> 9) & 1) << 5)); }
__host__ __device__ __forceinline__ void stage_rc(int b, int& R, int& C) { const int st = b / 1024, sb = b % 1024, swz = sb ^ (((sb >> 9) & 1) << 5); R = (st >> 1) * 16 + swz / 64; C = (st & 1) * 32 + (swz % 64) / 2; }
__host__ __device__ __forceinline__ int perm32(int rho) { const int n = rho >> 4, i = rho & 15; return 8 * (i >> 2) + 4 * n + (i & 3); }
struct Unit { int pm, pn; };
struct Gemm { const bf16_t* A; const bf16_t* Bt; int M, N, K, lda, ldb, a_pn_bytes, bsel_shift; int b_pn_rows = 1, b_pn_bytes = 0; };
struct StaticOrder {
    int nM, nN, nwg, G, c;
    __host__ __device__ void init(int M, int N, int G_, int c_) { nM = M / BM; nN = N / BM; nwg = nM * nN; G = G_; c = c_; }
    __host__ __device__ bool next(int i, Unit& u) const {
        const long L = (long)i * G + c; if (L >= nwg) return false;
        int wgid = (int)L; { const int q = nwg / NXCD, r = nwg % NXCD, xcd = wgid % NXCD, off = wgid / NXCD; wgid = (xcd < r ? xcd * (q + 1) : r * (q + 1) + (xcd - r) * q) + off; }
        const int nig = WGM * nN, gid = wgid / nig, fm = gid * WGM, gsz = (nM - fm) < WGM ? (nM - fm) : WGM;
        u.pm = fm + ((wgid % nig) % gsz); u.pn = (wgid % nig) / gsz; return true;
    }
    __device__ __forceinline__ void a_ready(const Unit&) const {}
    __device__ __forceinline__ void done(const Unit&) const {}
};
template <class Epi, class Sched, bool ALIGN_EPI = false, bool SP2 = false>
__device__ __forceinline__ void gemm_phase(PG8_LAS unsigned char* lds, const Gemm g, const Sched& S, const Epi& E) {
    const int tid = threadIdx.x, wid = __builtin_amdgcn_readfirstlane(tid >> 6), lane = tid & 63, wr = wid >> 2, wc = wid & 3, fr = lane & 15, fq = lane >> 4;
    const int K = g.K, nt = K / BK;
    unsigned voffA[2], voffB[2];
#pragma unroll
    for (int i = 0; i < 2; ++i) { int R, C; stage_rc(tid * 16 + i * 8192, R, C); const int Rb = Epi::PERM ? ((R & ~31) + perm32(R & 31)) : R;
        voffA[i] = (unsigned)(R * g.lda + C) * 2u; voffB[i] = (unsigned)(Rb * g.ldb + C) * 2u; }
    const size_t kstep = (size_t)(BK * 2);
    const size_t hstepA = (size_t)HALF * g.lda * 2, hstepB = (size_t)HALF * g.ldb * 2;
    const size_t tstepA = 2 * hstepA, tstepB = 2 * hstepB;
    const unsigned ldsw = (unsigned)wid * 1024u;
    const int aoff = lds_byte(wr * 64 + fr, fq * 8), boff = lds_byte(wc * 32 + fr, fq * 8);
#define PG8_UA(u) ((const char*)g.A + (size_t)(u).pm * tstepA + (size_t)(u).pn * (size_t)g.a_pn_bytes)
#define PG8_UB(u) ((const char*)g.Bt + (size_t)((u).pn * g.b_pn_rows + ((u).pm >> g.bsel_shift)) * tstepB + (size_t)(u).pn * (size_t)g.b_pn_bytes)
#define PG8_SA(b, h) (((b) * 2 + (h)) * HTB)
#define PG8_SB(b, h) ((4 + (b) * 2 + (h)) * HTB)
#define PG8_STAGE(bufoff, gbase, voff) do { _Pragma("unroll") for (int _i = 0; _i < 2; ++_i) \
        __builtin_amdgcn_global_load_lds((const unsigned*)((const char*)(gbase) + (voff)[_i]), (PG8_LAS unsigned*)(lds + (bufoff) + ldsw + _i * 8192), 16, 0, 0); } while (0)
#define PG8_LDA(dst, b, h) do { _Pragma("unroll") for (int m = 0; m < 4; ++m) _Pragma("unroll") for (int k = 0; k < 2; ++k) dst[m][k] = *(const PG8_LAS bf16x8*)(lds + PG8_SA(b, h) + aoff + m * 2048 + k * 1024); } while (0)
#define PG8_LDB(dst, b, h) do { _Pragma("unroll") for (int n = 0; n < 2; ++n) _Pragma("unroll") for (int k = 0; k < 2; ++k) dst[n][k] = *(const PG8_LAS bf16x8*)(lds + PG8_SB(b, h) + boff + n * 2048 + k * 1024); } while (0)
#define PG8_MMA(ai, bj, At, Bt) do { __builtin_amdgcn_s_setprio(1); _Pragma("unroll") for (int m = 0; m < 4; ++m) _Pragma("unroll") for (int n = 0; n < 2; ++n) _Pragma("unroll") for (int k = 0; k < 2; ++k) \
        acc[ai][bj][m][n] = __builtin_amdgcn_mfma_f32_16x16x32_bf16(Bt[n][k], At[m][k], acc[ai][bj][m][n], 0, 0, 0); __builtin_amdgcn_s_setprio(0); } while (0)
#define PG8_WAIT_V(n) asm volatile("s_waitcnt vmcnt(" #n ")" ::: "memory")
#define PG8_WAIT_L(n) asm volatile("s_waitcnt lgkmcnt(" #n ")" ::: "memory")
#define PG8_BAR __builtin_amdgcn_s_barrier()
#define PG8_SCHED __builtin_amdgcn_sched_barrier(0)
    Unit cur, nxt; int ui = 0;
    if (!S.next(0, cur)) return;
    f32x4 acc[2][2][4][2];
#pragma unroll
    for (int a = 0; a < 2; ++a)
#pragma unroll
        for (int b = 0; b < 2; ++b)
#pragma unroll
            for (int m = 0; m < 4; ++m)
#pragma unroll
                for (int n = 0; n < 2; ++n) acc[a][b][m][n] = (f32x4){0.f, 0.f, 0.f, 0.f};
    bf16x8 At[4][2], B0[2][2], B1[2][2];
    const char* cA = PG8_UA(cur); const char* cB = PG8_UB(cur);
    S.a_ready(cur);
    if constexpr (SP2) {
        PG8_STAGE(PG8_SB(0, 0), cB, voffB); PG8_STAGE(PG8_SB(0, 1), cB + hstepB, voffB); PG8_STAGE(PG8_SA(0, 0), cA, voffA); PG8_STAGE(PG8_SA(0, 1), cA + hstepA, voffA);
        if (wr == 1) PG8_BAR;
        PG8_WAIT_V(2); PG8_BAR;
        PG8_STAGE(PG8_SB(1, 0), cB + kstep, voffB); PG8_STAGE(PG8_SA(1, 0), cA + kstep, voffA); PG8_STAGE(PG8_SB(1, 1), cB + hstepB + kstep, voffB);
        PG8_WAIT_V(6); PG8_BAR;
    } else {
        PG8_STAGE(PG8_SB(0, 0), cB, voffB); PG8_STAGE(PG8_SA(0, 0), cA, voffA); PG8_STAGE(PG8_SB(0, 1), cB + hstepB, voffB); PG8_STAGE(PG8_SA(0, 1), cA + hstepA, voffA);
        if (wr == 1) PG8_BAR;
        PG8_WAIT_V(4); PG8_BAR;
        PG8_STAGE(PG8_SB(1, 0), cB + kstep, voffB); PG8_STAGE(PG8_SA(1, 0), cA + kstep, voffA); PG8_STAGE(PG8_SB(1, 1), cB + hstepB + kstep, voffB);
        PG8_WAIT_V(6); PG8_BAR;
    }
    for (;;) {
        const bool has_next = S.next(ui + 1, nxt);
        const char* nA = has_next ? PG8_UA(nxt) : cA; const char* nB = has_next ? PG8_UB(nxt) : cB;
        for (int t = 0; t < nt; t += 2) {
            const bool last = (t == nt - 2);
            const char* a1 = cA + (size_t)(t + 1) * kstep;
            const char* a2 = last ? nA : cA + (size_t)(t + 2) * kstep; const char* b2 = last ? nB : cB + (size_t)(t + 2) * kstep;
            const char* a3 = a2 + kstep; const char* b3 = b2 + kstep;
            if (last && has_next) S.a_ready(nxt);
            if constexpr (SP2) {
            PG8_LDB(B0, 0, 0); PG8_LDB(B1, 0, 1); PG8_SCHED; PG8_LDA(At, 0, 0); PG8_STAGE(PG8_SA(1, 1), a1 + hstepA, voffA);
            PG8_WAIT_V(8); PG8_WAIT_L(0); PG8_BAR; PG8_MMA(0, 0, At, B0); PG8_MMA(0, 1, At, B1); PG8_BAR; PG8_SCHED;
            PG8_LDA(At, 0, 1); PG8_STAGE(PG8_SB(0, 0), b2, voffB); PG8_STAGE(PG8_SB(0, 1), b2 + hstepB, voffB); PG8_STAGE(PG8_SA(0, 0), a2, voffA);
            PG8_WAIT_V(8); PG8_WAIT_L(0); PG8_BAR; PG8_MMA(1, 0, At, B0); PG8_MMA(1, 1, At, B1); PG8_BAR; PG8_SCHED;
            PG8_LDB(B0, 1, 0); PG8_LDB(B1, 1, 1); PG8_SCHED; PG8_LDA(At, 1, 0); PG8_STAGE(PG8_SA(0, 1), a2 + hstepA, voffA);
            PG8_WAIT_V(8); PG8_WAIT_L(0); PG8_BAR; PG8_MMA(0, 0, At, B0); PG8_MMA(0, 1, At, B1); PG8_BAR; PG8_SCHED;
            PG8_LDA(At, 1, 1); PG8_STAGE(PG8_SB(1, 0), b3, voffB); PG8_STAGE(PG8_SB(1, 1), b3 + hstepB, voffB); PG8_STAGE(PG8_SA(1, 0), a3, voffA);
            PG8_WAIT_V(8); PG8_WAIT_L(0); PG8_BAR; PG8_MMA(1, 0, At, B0); PG8_MMA(1, 1, At, B1); PG8_BAR; PG8_SCHED;
            } else {
            PG8_LDB(B0, 0, 0); PG8_SCHED; PG8_LDA(At, 0, 0); PG8_STAGE(PG8_SA(1, 1), a1 + hstepA, voffA);
            PG8_WAIT_L(8); PG8_BAR; PG8_WAIT_L(0); PG8_MMA(0, 0, At, B0); PG8_BAR; PG8_SCHED;
            PG8_LDB(B1, 0, 1); PG8_STAGE(PG8_SB(0, 0), b2, voffB);
            PG8_BAR; PG8_WAIT_L(0); PG8_MMA(0, 1, At, B1); PG8_BAR;
            PG8_LDA(At, 0, 1); PG8_STAGE(PG8_SA(0, 0), a2, voffA);
            PG8_BAR; PG8_WAIT_L(0); PG8_MMA(1, 0, At, B0); PG8_BAR; PG8_SCHED;
            PG8_STAGE(PG8_SB(0, 1), b2 + hstepB, voffB);
            PG8_WAIT_V(6); PG8_BAR; PG8_MMA(1, 1, At, B1); PG8_BAR;
            PG8_LDB(B0, 1, 0); PG8_SCHED; PG8_LDA(At, 1, 0); PG8_STAGE(PG8_SA(0, 1), a2 + hstepA, voffA);
            PG8_WAIT_L(8); PG8_BAR; PG8_WAIT_L(0); PG8_MMA(0, 0, At, B0); PG8_BAR; PG8_SCHED;
            PG8_LDB(B1, 1, 1); PG8_STAGE(PG8_SB(1, 0), b3, voffB);
            PG8_BAR; PG8_WAIT_L(0); PG8_MMA(0, 1, At, B1); PG8_BAR;
            PG8_LDA(At, 1, 1); PG8_STAGE(PG8_SA(1, 0), a3, voffA);
            PG8_BAR; PG8_WAIT_L(0); PG8_MMA(1, 0, At, B0); PG8_BAR; PG8_SCHED;
            PG8_STAGE(PG8_SB(1, 1), b3 + hstepB, voffB);
            PG8_WAIT_V(6); PG8_BAR; PG8_MMA(1, 1, At, B1); PG8_BAR;
            }
        }
        if constexpr (ALIGN_EPI) { if (wr == 0) PG8_BAR; }
        if constexpr (!Epi::AFTER_DRAIN) { E(acc, cur, wr, wc, fr, fq); S.done(cur); }
        if (!has_next) break;
#pragma unroll
        for (int a = 0; a < 2; ++a)
#pragma unroll
            for (int b = 0; b < 2; ++b)
#pragma unroll
                for (int m = 0; m < 4; ++m)
#pragma unroll
                    for (int n = 0; n < 2; ++n) acc[a][b][m][n] = (f32x4){0.f, 0.f, 0.f, 0.f};
        cur = nxt; cA = nA; cB = nB; ++ui;
        if constexpr (ALIGN_EPI) { if (wr == 1) PG8_BAR; }
    }
    PG8_WAIT_V(0);
    if constexpr (!ALIGN_EPI) { if (wr == 0) PG8_BAR; }
    PG8_BAR;
    if constexpr (Epi::AFTER_DRAIN) { E.fused(acc, cur, wr, wc, fr, fq, lds, wid, lane); S.done(cur); }
#undef PG8_SA
#undef PG8_UA
#undef PG8_UB
#undef PG8_SB
#undef PG8_STAGE
#undef PG8_LDA
#undef PG8_LDB
#undef PG8_MMA
#undef PG8_WAIT_V
#undef PG8_WAIT_L
#undef PG8_BAR
#undef PG8_SCHED
}
}

constexpr int BATCH = 2, SEQ = 16384, DM = 1024, MT = BATCH * SEQ, FFH = 2816, INC = 2848;
constexpr int PROJ_LD = 2048;
constexpr int NPROJ = 3072;
constexpr float L2E = 1.4426950408889634f;
constexpr float C2 = 0.125f * L2E;
constexpr float RMS_EPS = 1e-6f;
constexpr size_t MiB = 1u << 20;
constexpr size_t WS_CTL = 0, CTL_BYTES = 65536;
constexpr size_t WS_WIN_T = 1 * MiB, WS_WOUT_T = 7 * MiB, WS_POOL_T = 9 * MiB, WS_W1_T = 10 * MiB;
constexpr size_t WS_GU_T = 12 * MiB, GU_T_STRIDE = 12 * MiB, WS_DN_T = 36 * MiB, DN_T_STRIDE = 6 * MiB;
constexpr size_t WS_LOGF = 48 * MiB, WS_C = 49 * MiB, WS_CBIAS = 50 * MiB, WS_KC = 50 * MiB + 65536, WS_VCT = 51 * MiB, WS_SMASK = 52 * MiB, WS_HIDC = 54 * MiB;
constexpr size_t WS_U = 56 * MiB;
constexpr size_t WS_PROJ = 120 * MiB;
constexpr size_t WS_VT = WS_PROJ + 128 * MiB;
constexpr size_t WS_HID = WS_PROJ, WS_POOLED = WS_PROJ;
constexpr size_t WS_CMPIN = 296 * MiB;
constexpr size_t WS_MOUT = 314 * MiB;
constexpr size_t WS_PART = WS_MOUT;
constexpr size_t WS_HIDP = 380 * MiB;
constexpr size_t WS_H16 = 442 * MiB;
constexpr size_t WS_END = 506 * MiB;
constexpr int CW_Q3 = 0, CW_Q4 = 64, CW_Q5 = 128, CW_NRM = 192, CW_PPDONE = 320, CW_BAR = 1024, CW_PANEL = 12288;

struct Params {
    const float* x; const float* norm_g; const float* w_in; const float* b_f; const float* cmp_pe; const float* cmp_w1; const float* cmp_w2;
    const float* w_out; const float* pool_w; const float* pool_scale; const float* w_gate; const float* w_up; const float* w_down;
    float* out; unsigned char* ws; int ph_lo, ph_hi, bar_region, pad_;
};

namespace pg8 {
__device__ __forceinline__ unsigned cvt_pk_bf16(float lo, float hi) { return pk_bf16(lo, hi); }
#define EPI_ROWS_BEGIN \
    _Pragma("unroll") for (int ai = 0; ai < 2; ++ai) _Pragma("unroll") for (int m = 0; m < 4; ++m) { const int row = u.pm * BM + ai * HALF + wr * 64 + m * 16 + fr; \
    _Pragma("unroll") for (int bj = 0; bj < 2; ++bj) { const int colt = bj * HALF + wc * 32 + 8 * fq; const f32x4 v0 = acc[ai][bj][m][0], v1 = acc[ai][bj][m][1];
#define EPI_ROWS_END } }

struct EpiInProj {
    static constexpr bool PERM = true, AFTER_DRAIN = false;
    bf16_t* proj; bf16_t* vt; bf16_t* cmpin;
    __device__ __forceinline__ void operator()(const f32x4 (&acc)[2][2][4][2], const Unit& u, int wr, int wc, int fr, int fq) const {
        const int pn = u.pn;
        if (pn < 8) {
            const float qsc = (pn < 2 || pn == 4 || pn == 5) ? C2 : 1.f;
            EPI_ROWS_BEGIN
                u32x4 w; w.x = cvt_pk_bf16(v0[0] * qsc, v0[1] * qsc); w.y = cvt_pk_bf16(v0[2] * qsc, v0[3] * qsc); w.z = cvt_pk_bf16(v1[0] * qsc, v1[1] * qsc); w.w = cvt_pk_bf16(v1[2] * qsc, v1[3] * qsc);
                *(u32x4*)(proj + (size_t)row * PROJ_LD + pn * 256 + colt) = w;
            EPI_ROWS_END
        } else if (pn < 11) {
            EPI_ROWS_BEGIN
                const int cc = (pn - 8) * 256 + colt, vh = cc >> 6, d = cc & 63, b = row >> 14, t = row & (SEQ - 1);
                bf16_t* dst = vt + ((size_t)(b * 12 + vh) * 64 + d) * SEQ + t;
                const unsigned w0 = cvt_pk_bf16(v0[0], v0[1]), w1 = cvt_pk_bf16(v0[2], v0[3]), w2 = cvt_pk_bf16(v1[0], v1[1]), w3 = cvt_pk_bf16(v1[2], v1[3]);
                dst[0 * (size_t)SEQ] = (bf16_t)(w0 & 0xffffu); dst[1 * (size_t)SEQ] = (bf16_t)(w0 >> 16);
                dst[2 * (size_t)SEQ] = (bf16_t)(w1 & 0xffffu); dst[3 * (size_t)SEQ] = (bf16_t)(w1 >> 16);
                dst[4 * (size_t)SEQ] = (bf16_t)(w2 & 0xffffu); dst[5 * (size_t)SEQ] = (bf16_t)(w2 >> 16);
                dst[6 * (size_t)SEQ] = (bf16_t)(w3 & 0xffffu); dst[7 * (size_t)SEQ] = (bf16_t)(w3 >> 16);
            EPI_ROWS_END
        } else {
            EPI_ROWS_BEGIN
                const int which = colt >> 7, g = (colt >> 6) & 1, d = colt & 63, b = row >> 14, t = row & (SEQ - 1);
                u32x4 w; w.x = cvt_pk_bf16(v0[0], v0[1]); w.y = cvt_pk_bf16(v0[2], v0[3]); w.z = cvt_pk_bf16(v1[0], v1[1]); w.w = cvt_pk_bf16(v1[2], v1[3]);
                *(u32x4*)(cmpin + ((size_t)((which * 2 + b) * 2 + g) * SEQ + t) * 64 + d) = w;
            EPI_ROWS_END
        }
    }
};
struct EpiBf16M {
    static constexpr bool PERM = true, AFTER_DRAIN = false;
    bf16_t* out; int ldc;
    __device__ __forceinline__ void operator()(const f32x4 (&acc)[2][2][4][2], const Unit& u, int wr, int wc, int fr, int fq) const {
        EPI_ROWS_BEGIN
            u32x4 w; w.x = cvt_pk_bf16(v0[0], v0[1]); w.y = cvt_pk_bf16(v0[2], v0[3]); w.z = cvt_pk_bf16(v1[0], v1[1]); w.w = cvt_pk_bf16(v1[2], v1[3]);
            *(u32x4*)(out + (size_t)row * ldc + u.pn * BM + colt) = w;
        EPI_ROWS_END
    }
};
struct EpiF32 {
    static constexpr bool PERM = true, AFTER_DRAIN = false;
    float* out; int ldc; const float* cscale;
    __device__ __forceinline__ void operator()(const f32x4 (&acc)[2][2][4][2], const Unit& u, int wr, int wc, int fr, int fq) const {
        EPI_ROWS_BEGIN
            const int col = u.pn * BM + colt; f32x4 a = v0, b = v1;
            if (cscale) { a = a * *(const f32x4*)(cscale + col); b = b * *(const f32x4*)(cscale + col + 4); }
            float* p = out + (size_t)row * ldc + col; *(f32x4*)p = a; *(f32x4*)(p + 4) = b;
        EPI_ROWS_END
    }
};
__device__ __forceinline__ float silu_f(float x) { return x * __builtin_amdgcn_rcpf(1.f + __builtin_amdgcn_exp2f(-x * L2E)); }
struct EpiSwiGLU {
    static constexpr bool PERM = true, AFTER_DRAIN = false;
    bf16_t* hid; const float* rstd;
    __device__ __forceinline__ void operator()(const f32x4 (&acc)[2][2][4][2], const Unit& u, int wr, int wc, int fr, int fq) const {
        EPI_ROWS_BEGIN
            const int hc = (u.pn * BM + colt) >> 1; const float r = 1.f / sqrtf(rstd[row] * (1.f / DM) + RMS_EPS);
            const float h0 = silu_f(v0[0] * r) * (v0[1] * r), h1 = silu_f(v0[2] * r) * (v0[3] * r), h2 = silu_f(v1[0] * r) * (v1[1] * r), h3 = silu_f(v1[2] * r) * (v1[3] * r);
            u32x2 w; w.x = cvt_pk_bf16(h0, h1); w.y = cvt_pk_bf16(h2, h3);
            *(u32x2*)(hid + (size_t)row * FFH + hc) = w;
        EPI_ROWS_END
    }
};
__device__ __forceinline__ float gelu_tanh_f(float x) {
    const float y = 0.7978845608028654f * (x + 0.044715f * x * x * x);
    const float e = __expf(2.f * y);
    const float th = 1.f - 2.f / (1.f + e);
    return 0.5f * x * (1.f + th);
}
struct EpiCompress {
    static constexpr bool PERM = true, AFTER_DRAIN = false;
    float* hidp;
    __device__ __forceinline__ void operator()(const f32x4 (&acc)[2][2][4][2], const Unit& u, int wr, int wc, int fr, int fq) const {
        EPI_ROWS_BEGIN
            if (colt < 64) { float* p = hidp + ((size_t)u.pn * 8192 + row) * 64 + colt; *(f32x4*)p = v0; *(f32x4*)(p + 4) = v1; }
        EPI_ROWS_END
    }
};
}

DI float wave_sum(float v) {
#pragma unroll
    for (int o = 1; o < 64; o <<= 1) v += __shfl_xor(v, o);
    return v;
}
DI float exp2_fast(float x) { return __builtin_amdgcn_exp2f(x); }

struct Seg { int inp; int srcoff; int ldw; int K; int src0; int len; int dstoff_kb; int ldwt; int dst0; int dstride; int scoff; int gkoff; };
#define SEG_IN(src0, len, dst0) {2, 0, INC, 1024, src0, len, (int)(WS_WIN_T / 1024), 1024, dst0, 1, -1, -1}
__constant__ Seg SEGS[] = {
    SEG_IN(0, 512, 0), SEG_IN(512, 512, 512), SEG_IN(1544, 512, 1024), SEG_IN(2312, 128, 1536), SEG_IN(2568, 128, 1664), SEG_IN(2824, 24, 1792),
    SEG_IN(1024, 512, 2048), SEG_IN(2440, 128, 2560), SEG_IN(2696, 128, 2688), SEG_IN(2056, 128, 2816), SEG_IN(2184, 128, 2944),
    {7, 0, 1024, 1024, 0, 1024, (int)(WS_WOUT_T / 1024), 1024, 0, 1, -1, -1},
    {8, 0 * 65536, 256, 256, 0, 256, (int)(WS_POOL_T / 1024), 256, 0, 1, 0, 4 * DM + 0}, {8, 1 * 65536, 256, 256, 0, 256, (int)(WS_POOL_T / 1024), 256, 256, 1, 256, 4 * DM + 256},
    {8, 2 * 65536, 256, 256, 0, 256, (int)(WS_POOL_T / 1024), 256, 512, 1, 512, 4 * DM + 512}, {8, 3 * 65536, 256, 256, 0, 256, (int)(WS_POOL_T / 1024), 256, 768, 1, 768, 4 * DM + 768},
    {5, 0, 64, 2048, 0, 64, (int)(WS_W1_T / 1024), 2048, 0, 1, -1, -1}, {5, 2048 * 64, 64, 2048, 0, 64, (int)(WS_W1_T / 1024), 2048, 256, 1, -1, -1},
    {10, 0, FFH, 1024, 0, FFH, (int)(WS_GU_T / 1024), 1024, 0, 2, -1, 2 * DM}, {11, 0, FFH, 1024, 0, FFH, (int)(WS_GU_T / 1024), 1024, 1, 2, -1, 2 * DM},
    {10, 1024 * FFH, FFH, 1024, 0, FFH, (int)((WS_GU_T + GU_T_STRIDE) / 1024), 1024, 0, 2, -1, 6 * DM}, {11, 1024 * FFH, FFH, 1024, 0, FFH, (int)((WS_GU_T + GU_T_STRIDE) / 1024), 1024, 1, 2, -1, 6 * DM},
    {12, 0, 1024, FFH, 0, 1024, (int)(WS_DN_T / 1024), FFH, 0, 1, -1, -1}, {12, FFH * 1024, 1024, FFH, 0, 1024, (int)((WS_DN_T + DN_T_STRIDE) / 1024), FFH, 0, 1, -1, -1},
};
constexpr int NSEG = 24;

DI void transpose_item(const float* W, int ldw, int src0, int len, bf16_t* WT, int ldwt, int dst0, int dstride, const float* csc, const float* gk, LAS float* scr, int kb, int nb, int lane) {
    const int k0 = 64 * kb, n0 = 32 * nb;
    const bool okc = (n0 + (lane & 31)) < len;
    const float cs_ = (csc && okc) ? csc[n0 + (lane & 31)] : 1.f;
    float tv[32];
#pragma unroll
    for (int i = 0; i < 32; ++i) { const int kk = 2 * i + (lane >> 5); tv[i] = okc ? W[(size_t)(k0 + kk) * ldw + src0 + n0 + (lane & 31)] : 0.f; }
#pragma unroll
    for (int i = 0; i < 32; ++i) { const int kk = 2 * i + (lane >> 5); scr[kk * 33 + (lane & 31)] = tv[i] * cs_ * (gk ? gk[k0 + kk] : 1.f); }
    asm volatile("s_waitcnt lgkmcnt(0)" ::: "memory");
    const int c = lane & 7;
#pragma unroll
    for (int j = 0; j < 4; ++j) { const int n = (lane >> 3) + 8 * j; const LAS float* s = scr + (8 * c) * 33 + n;
        u32x4 o; o.x = pk_bf16(s[0 * 33], s[1 * 33]); o.y = pk_bf16(s[2 * 33], s[3 * 33]); o.z = pk_bf16(s[4 * 33], s[5 * 33]); o.w = pk_bf16(s[6 * 33], s[7 * 33]);
        if (n0 + n < len) *(u32x4*)(WT + (size_t)(dst0 + dstride * (n0 + n)) * ldwt + k0 + 8 * c) = o; }
    asm volatile("s_waitcnt lgkmcnt(0)" ::: "memory");
}

constexpr int KPB = 144;
constexpr int TILE_B = 64 * KPB;
constexpr int AL_K = 0, AL_V = 2 * TILE_B, AL_CS = 4 * TILE_B, AL_MISC = AL_CS + 512, AL_PSL = AL_MISC + 512, PSL_P = 65, AL_SM = AL_PSL + 257 * PSL_P * 4, AL_LIST = AL_SM + 64 * 8 * 4, AL_TMP = AL_LIST + 1024 + 64, AL_END = AL_TMP + 2 * 8 * 17 * 32 * 4;

#define MFMA32(a, b, c) __builtin_amdgcn_mfma_f32_32x32x16_bf16((a), (b), (c), 0, 0, 0)

DI void tile_gload(u32x4& kr, u32x4& vr, const bf16_t* kbase, size_t kpitch, const bf16_t* vbase, size_t vpitch, int tid) {
    const int row = tid >> 3, ch = tid & 7;
    kr = *(const u32x4*)(kbase + (size_t)row * kpitch + ch * 8);
    vr = *(const u32x4*)(vbase + (size_t)row * vpitch + ch * 8);
}
DI void tile_lstore(lptr kb, lptr vb, const u32x4& kr, const u32x4& vr, int tid) {
    const int row = tid >> 3, ch = tid & 7;
    *(LAS u32x4*)(kb + row * KPB + ch * 16) = kr; *(LAS u32x4*)(vb + row * KPB + ch * 16) = vr;
}
DI void qk_acc(lptr Kt, const bf16x8 (&qf)[4], f32x16& s0, f32x16& s1, int lane) {
    const int i = lane & 31, hi = lane >> 5;
    const int krow = (i & 19) | ((i & 4) << 1) | ((i & 8) >> 1);
    lptr kp = Kt + krow * KPB + hi * 16;
    bf16x8 a0[4], a1[4];
#pragma unroll
    for (int d0 = 0; d0 < 4; ++d0) { a0[d0] = *(LAS bf16x8*)(kp + d0 * 32); a1[d0] = *(LAS bf16x8*)(kp + 32 * KPB + d0 * 32); }
    __builtin_amdgcn_s_setprio(1);
#pragma unroll
    for (int d0 = 0; d0 < 4; ++d0) { s0 = MFMA32(a0[d0], qf[d0], s0); s1 = MFMA32(a1[d0], qf[d0], s1); }
    __builtin_amdgcn_s_setprio(0);
}
DI bf16x8 pack8(const f32x16& p, int base) {
    u32x4 w; w.x = pk_bf16(p[base + 0], p[base + 1]); w.y = pk_bf16(p[base + 2], p[base + 3]); w.z = pk_bf16(p[base + 4], p[base + 5]); w.w = pk_bf16(p[base + 6], p[base + 7]);
    return __builtin_bit_cast(bf16x8, w);
}
DI void pv_tile(lptr Vt, const f32x16& p0, const f32x16& p1, f32x16& o0, f32x16& o1, int lane) {
    const int i = lane & 31, hi = lane >> 5;
    lptr vp = Vt + i * KPB + hi * 16;
    {
        const bf16x8 pf = pack8(p0, 0); const bf16x8 v0 = *(LAS bf16x8*)(vp + 0), v1 = *(LAS bf16x8*)(vp + 32 * KPB + 0);
        o0 = MFMA32(v0, pf, o0); o1 = MFMA32(v1, pf, o1);
    }
    {
        const bf16x8 pf = pack8(p0, 8); const bf16x8 v0 = *(LAS bf16x8*)(vp + 32), v1 = *(LAS bf16x8*)(vp + 32 * KPB + 32);
        o0 = MFMA32(v0, pf, o0); o1 = MFMA32(v1, pf, o1);
    }
    {
        const bf16x8 pf = pack8(p1, 0); const bf16x8 v0 = *(LAS bf16x8*)(vp + 64), v1 = *(LAS bf16x8*)(vp + 32 * KPB + 64);
        o0 = MFMA32(v0, pf, o0); o1 = MFMA32(v1, pf, o1);
    }
    {
        const bf16x8 pf = pack8(p1, 8); const bf16x8 v0 = *(LAS bf16x8*)(vp + 96), v1 = *(LAS bf16x8*)(vp + 32 * KPB + 96);
        o0 = MFMA32(v0, pf, o0); o1 = MFMA32(v1, pf, o1);
    }
}
struct TP { float fb, sl; int lim, lim2; bool sel; const LAS float* cs; };
struct RowState { float mref, l; bool seen; };
template <int MODE>
DI void bias_init(f32x16& s0, f32x16& s1, const TP& tp, float fbm, int hi) {
#pragma unroll
    for (int r = 0; r < 16; ++r) {
        const int kvc = 16 * (r >> 3) + (r & 7);
        if (MODE == 0) { s0[r] = __builtin_fmaf(-L2E, tp.cs[kvc + 8 * hi], fbm); s1[r] = __builtin_fmaf(-L2E, tp.cs[kvc + 32 + 8 * hi], fbm); }
        else { s0[r] = __builtin_fmaf(tp.sl, (float)kvc, fbm); s1[r] = __builtin_fmaf(tp.sl, (float)(kvc + 32), fbm); }
    }
}
DI float max3_asm(float a, float b, float c) { float r; asm("v_max3_f32 %0, %1, %2, %3" : "=v"(r) : "v"(a), "v"(b), "v"(c)); return r; }
template <bool MASK>
DI float mask_rowmax(f32x16& s0, f32x16& s1, const TP& tp) {
    if (MASK) {
#pragma unroll
        for (int r = 0; r < 16; ++r) {
            const int kvc = 16 * (r >> 3) + (r & 7);
            const bool v0 = tp.sel && (kvc <= tp.lim) && (kvc > tp.lim2), v1 = tp.sel && (kvc + 32 <= tp.lim) && (kvc + 32 > tp.lim2);
            s0[r] = v0 ? s0[r] : -1e30f; s1[r] = v1 ? s1[r] : -1e30f;
        }
    }
    const float seed = __builtin_fminf(s0[15], s1[15]);
    float ma = seed, mb = seed;
#pragma unroll
    for (int r = 0; r < 16; r += 2) { ma = max3_asm(ma, s0[r], s1[r]); mb = max3_asm(mb, s0[r + 1], s1[r + 1]); }
    const float mx = fmaxf(ma, mb);
    return fmaxf(mx, __shfl_xor(mx, 32));
}
template <int MODE, bool MASK, bool WITH_O>
DI void attn_tile_t(lptr Kt, lptr Vt, const bf16x8 (&qf)[4], f32x16& o0, f32x16& o1, RowState& rs, const TP& tp, int lane) {
    const int hi = lane >> 5;
    f32x16 s0, s1;
    bias_init<MODE>(s0, s1, tp, tp.fb - rs.mref, hi);
    qk_acc(Kt, qf, s0, s1, lane);
    const float mx = mask_rowmax<MASK>(s0, s1, tp);
    const bool was = rs.seen; rs.seen = was || (mx > -1e29f);
    const bool trig = (mx > 8.f) || (!was && mx > -1e29f && mx < -8.f);
    if (__builtin_expect(__any(trig), 0)) {
        asm volatile("" ::: "memory");
        const float d = trig ? mx : 0.f; rs.mref += d;
        const float al = was ? exp2_fast(-d) : 1.f; rs.l *= al;
        if (WITH_O) { o0 = o0 * al; o1 = o1 * al; }
#pragma unroll
        for (int r = 0; r < 16; ++r) { s0[r] -= d; s1[r] -= d; }
    }
    if (!WITH_O) {
        float sum = 0.f;
#pragma unroll
        for (int r = 0; r < 16; ++r) { s0[r] = exp2_fast(s0[r]); s1[r] = exp2_fast(s1[r]); sum += s0[r] + s1[r]; }
        rs.l += sum;
    } else {
        const int i = lane & 31;
        lptr vp = Vt + i * KPB + hi * 16;
        float sum = 0.f;
#define PV_STEP(S, BASE, JOFF) { \
            const bf16x8 v0 = *(LAS bf16x8*)(vp + (JOFF)), v1 = *(LAS bf16x8*)(vp + 32 * KPB + (JOFF)); \
            _Pragma("unroll") for (int e = 0; e < 8; ++e) { S[(BASE) + e] = exp2_fast(S[(BASE) + e]); sum += S[(BASE) + e]; } \
            const bf16x8 pf = pack8(S, (BASE)); \
            o0 = MFMA32(v0, pf, o0); o1 = MFMA32(v1, pf, o1); \
            __builtin_amdgcn_sched_barrier(0); }
        PV_STEP(s0, 0, 0) PV_STEP(s0, 8, 32) PV_STEP(s1, 0, 64) PV_STEP(s1, 8, 96)
#undef PV_STEP
        rs.l += sum;
    }
}
template <int MODE>
DI void attn_tile(lptr Kt, lptr Vt, const bf16x8 (&qf)[4], f32x16& o0, f32x16& o1, RowState& rs, const TP& tp, bool need_mask, int lane) {
    if (need_mask) attn_tile_t<MODE, true, true>(Kt, Vt, qf, o0, o1, rs, tp, lane);
    else attn_tile_t<MODE, false, true>(Kt, Vt, qf, o0, o1, rs, tp, lane);
}
DI void load_q(bf16x8 (&qf)[4], const bf16_t* qrow, int hi) {
#pragma unroll
    for (int d0 = 0; d0 < 4; ++d0) qf[d0] = *(const bf16x8*)(qrow + d0 * 16 + hi * 8);
}

#define ATT_LOOP_BEGIN(NT, HASCS, KPTR_EXPR, VPTR_EXPR, CS_EXPR) \
  { u32x4 kr_, vr_; float csr_ = 0.f; \
    { const int jt = 0; (void)jt; tile_gload(kr_, vr_, (KPTR_EXPR), kpitch_, (VPTR_EXPR), vpitch_, tid); if (HASCS && tid < 64) csr_ = (CS_EXPR)[tid]; } \
    tile_lstore(L + AL_K, L + AL_V, kr_, vr_, tid); if (HASCS && tid < 64) ((LAS float*)(L + AL_CS))[tid] = csr_; \
    __syncthreads(); \
    for (int jt_ = 0; jt_ < (NT); ++jt_) { const int cur_ = jt_ & 1; \
      if (jt_ + 1 < (NT)) { const int jt = jt_ + 1; (void)jt; tile_gload(kr_, vr_, (KPTR_EXPR), kpitch_, (VPTR_EXPR), vpitch_, tid); if (HASCS && tid < 64) csr_ = (CS_EXPR)[tid]; } \
      { const int jt = jt_; (void)jt; lptr Kt = L + AL_K + cur_ * TILE_B; lptr Vt = L + AL_V + cur_ * TILE_B; const LAS float* csb = (const LAS float*)(L + AL_CS) + cur_ * 64; (void)Kt; (void)Vt; (void)csb;
#define ATT_LOOP_END(NT, HASCS) } \
      if (jt_ + 1 < (NT)) { tile_lstore(L + AL_K + (cur_ ^ 1) * TILE_B, L + AL_V + (cur_ ^ 1) * TILE_B, kr_, vr_, tid); if (HASCS && tid < 64) ((LAS float*)(L + AL_CS))[(cur_ ^ 1) * 64 + tid] = csr_; } \
      __syncthreads(); } }

DI void store_o_bf16(bf16_t* orow, const f32x16& o0, const f32x16& o1, float sc, int hi) {
#pragma unroll
    for (int g4 = 0; g4 < 4; ++g4) {
        u32x2 w0, w1;
        w0.x = pk_bf16(o0[4 * g4] * sc, o0[4 * g4 + 1] * sc); w0.y = pk_bf16(o0[4 * g4 + 2] * sc, o0[4 * g4 + 3] * sc);
        w1.x = pk_bf16(o1[4 * g4] * sc, o1[4 * g4 + 1] * sc); w1.y = pk_bf16(o1[4 * g4 + 2] * sc, o1[4 * g4 + 3] * sc);
        *(u32x2*)(orow + 8 * g4 + 4 * hi) = w0; *(u32x2*)(orow + 32 + 8 * g4 + 4 * hi) = w1;
    }
}
DI float sigmoid_f(float x) { return 1.f / (1.f + __expf(-x)); }

DI void fox_unit(const Params& P, lptr L, int u, int tid, int lane, int wid) {
    unsigned char* ws = P.ws;
    const bf16_t* PROJ = (const bf16_t*)(ws + WS_PROJ); const bf16_t* VT = (const bf16_t*)(ws + WS_VT); bf16_t* ATT = (bf16_t*)(ws + WS_U);
    const float* CARR = (const float*)(ws + WS_C); const unsigned* CTL = (const unsigned*)(ws + WS_CTL);
    const int bh = u & 15, b = bh >> 3, h = bh & 7, qt = 63 - (u >> 4);
    const int i = lane & 31, hi = lane >> 5;
    const int t0 = qt * 256, tq0 = t0 + wid * 32, t = tq0 + i;
    const float* carr = CARR + (size_t)(b * 8 + h) * SEQ;
    volatile LAS int* misc = (volatile LAS int*)(L + AL_MISC);
    if (tid == 0) misc[0] = t0 >> 6;
    __syncthreads();
    {
        const float qn2 = __uint_as_float(CTL[CW_NRM + b * 16 + h]), kn2 = __uint_as_float(CTL[CW_NRM + b * 16 + 8 + h]);
        const float bnd = 2.f * sqrtf(qn2 * kn2) * (1.01f / L2E) + 0.5f;
        const int ntl = t0 >> 6;
        if (tid < ntl) { if (carr[t0] - carr[64 * tid + 63] + bnd >= -30.f)     __hip_atomic_fetch_min((LAS int*)(L + AL_MISC), tid, __ATOMIC_RELAXED, __HIP_MEMORY_SCOPE_WORKGROUP); }
    }
    __syncthreads();
    const int jlo = misc[0], jhi = 4 * qt + 3, NT = jhi - jlo + 1;
    const int jw_hi = (tq0 + 31) >> 6;
    bf16x8 qf[4]; load_q(qf, PROJ + (size_t)(b * SEQ + t) * PROJ_LD + h * 64, hi);
    const float ct = carr[t] * L2E;
    f32x16 o0, o1;
#pragma unroll
    for (int r = 0; r < 16; ++r) { o0[r] = 0.f; o1[r] = 0.f; }
    RowState rs; rs.mref = 0.f; rs.l = 0.f; rs.seen = false;
    const bf16_t* kb_ = PROJ + (size_t)(b * SEQ) * PROJ_LD + 512 + h * 64; const size_t kpitch_ = PROJ_LD;
    const bf16_t* vb_ = VT + (size_t)((b * 12 + h) * 64) * SEQ; const size_t vpitch_ = SEQ;
    ATT_LOOP_BEGIN(NT, true, kb_ + (size_t)((jlo + jt) * 64) * PROJ_LD, vb_ + (size_t)(jlo + jt) * 64, carr + (jlo + jt) * 64)
        const int j = jlo + jt, kv0 = j * 64;
        if (j <= jw_hi) {
            TP tp; tp.fb = ct; tp.sl = 0.f; tp.lim = t - kv0 - 8 * hi; tp.lim2 = -(1 << 30); tp.sel = true; tp.cs = csb;
            attn_tile<0>(Kt, Vt, qf, o0, o1, rs, tp, kv0 + 63 > tq0, lane);
        }
    ATT_LOOP_END(NT, true)
    float l = rs.l; l += __shfl_xor(l, 32);
    const float inv = 1.f / fmaxf(l, 1e-30f);
    store_o_bf16(ATT + (size_t)(b * SEQ + t) * DM + h * 64, o0, o1, inv, hi);
}

DI void cmpwin_unit(const Params& P, lptr L, int u, int tid, int lane, int wid) {
    unsigned char* ws = P.ws;
    const bf16_t* PROJ = (const bf16_t*)(ws + WS_PROJ); const bf16_t* VT = (const bf16_t*)(ws + WS_VT);
    const bf16_t* KC = (const bf16_t*)(ws + WS_KC); const bf16_t* VCT = (const bf16_t*)(ws + WS_VCT);
    float* PART = (float*)(ws + WS_PART);
    const int bg = u & 3, b = bg >> 1, g = bg & 1, qb = 255 - (u >> 2);
    const int r4 = wid & 3, qs = wid >> 2, i = lane & 31, hi = lane >> 5;
    const int head = g * 4 + r4, tq0 = qb * 64 + qs * 32, t = tq0 + i, ql = qs * 32 + i;
    const size_t row = (size_t)b * SEQ + t;
    const float slope = exp2f(-(float)(head + 1)), sl = slope * L2E;
    bf16x8 qf[4]; load_q(qf, PROJ + row * PROJ_LD + 1024 + head * 64, hi);
    const bf16_t* grow = PROJ + row * PROJ_LD + 1792 + head * 3;
    const float gc = sigmoid_f(bf2f(grow[0])), gwn = sigmoid_f(bf2f(grow[2]));
    LAS float* psl = (LAS float*)(L + AL_PSL);
    const int nlim = (t >= 31) ? min((t - 31) >> 4, 1022) : -1;
    const int NTC = ((4 * qb + 2) >> 6) + 1;
    for (int rp_ = 0; rp_ < ((PROBE_SUB & 1) ? 2 : 1); ++rp_)
    {
        const bf16_t* kb_ = KC + (size_t)((b * 2 + g) * 1024) * 64; const size_t kpitch_ = 64;
        const bf16_t* vb_ = VCT + (size_t)((b * 2 + g) * 64) * 1024; const size_t vpitch_ = 1024;
        const int nfull = (tq0 - 31) >> 4;
        RowState rs; rs.mref = 0.f; rs.l = 0.f; rs.seen = false;
        f32x16 od0, od1;
        ATT_LOOP_BEGIN(NTC, false, kb_ + (size_t)(jt * 64) * 64, vb_ + (size_t)jt * 64, (const float*)nullptr)
            const int n0 = jt * 64;
            TP tp; tp.cs = nullptr; tp.sl = 16.f * sl; tp.fb = sl * (float)(16 * (n0 + 8 * hi) + 31 - t); tp.lim = nlim - n0 - 8 * hi; tp.lim2 = -(1 << 30); tp.sel = true;
            if (n0 + 63 <= nfull) attn_tile_t<1, false, false>(Kt, Vt, qf, od0, od1, rs, tp, lane);
            else attn_tile_t<1, true, false>(Kt, Vt, qf, od0, od1, rs, tp, lane);
        ATT_LOOP_END(NTC, false)
        float l = rs.l; l += __shfl_xor(l, 32);
        const float mfin = (l > 0.f) ? rs.mref + __builtin_amdgcn_logf(l) : 0.f;
        for (int e = tid; e < 257 * PSL_P; e += 512) psl[e] = 0.f;
        __syncthreads();
        f32x16 o0, o1;
#pragma unroll
        for (int r = 0; r < 16; ++r) { o0[r] = 0.f; o1[r] = 0.f; }
        ATT_LOOP_BEGIN(NTC, false, kb_ + (size_t)(jt * 64) * 64, vb_ + (size_t)jt * 64, (const float*)nullptr)
            const int n0 = jt * 64;
            TP tp; tp.cs = nullptr; tp.sl = 16.f * sl; tp.fb = sl * (float)(16 * (n0 + 8 * hi) + 31 - t); tp.lim = nlim - n0 - 8 * hi; tp.lim2 = -(1 << 30); tp.sel = true;
            f32x16 s0, s1;
            bias_init<1>(s0, s1, tp, tp.fb - mfin, hi);
            qk_acc(Kt, qf, s0, s1, lane);
            if (n0 + 63 > nfull) (void)mask_rowmax<true>(s0, s1, tp);
#pragma unroll
            for (int r = 0; r < 16; ++r) { s0[r] = exp2_fast(s0[r]); s1[r] = exp2_fast(s1[r]); }
            {
                if (jt > 0) {
                    const LAS float* tp_ = (const LAS float*)(L + AL_TMP) + (cur_ ^ 1) * (8 * 17 * 32);
                    for (int e = tid; e < 2 * 17 * 32; e += 512) { const int q32 = e & 31, jl = (e >> 5) % 17, qh = e / (17 * 32);
                        const float a = (tp_[((qh * 4 + 0) * 17 + jl) * 32 + q32] + tp_[((qh * 4 + 1) * 17 + jl) * 32 + q32]) + (tp_[((qh * 4 + 2) * 17 + jl) * 32 + q32] + tp_[((qh * 4 + 3) * 17 + jl) * 32 + q32]);
                        psl[((n0 - 64) / 4 + jl) * PSL_P + qh * 32 + q32] += a; }
                }
                LAS float* tw = (LAS float*)(L + AL_TMP) + (cur_ * 8 + wid) * (17 * 32) + i;
                const float c0 = s0[7], c1 = s0[15], c2 = s1[7], c3 = s1[15];
                const float x0 = __shfl_xor(c0, 32), x1 = __shfl_xor(c1, 32), x2 = __shfl_xor(c2, 32), x3 = __shfl_xor(c3, 32);
                const float in0 = hi ? x0 : 0.f, in1 = hi ? x1 : x0, in2 = hi ? x2 : x1, in3 = hi ? x3 : x2;
                const float a0 = (s0[0] + s0[1]) + (s0[2] + s0[3]) + in0, b0 = (s0[4] + s0[5]) + (s0[6] + s0[7]) + s0[3];
                const float a1 = (s0[8] + s0[9]) + (s0[10] + s0[11]) + in1, b1 = (s0[12] + s0[13]) + (s0[14] + s0[15]) + s0[11];
                const float a2 = (s1[0] + s1[1]) + (s1[2] + s1[3]) + in2, b2 = (s1[4] + s1[5]) + (s1[6] + s1[7]) + s1[3];
                const float a3 = (s1[8] + s1[9]) + (s1[10] + s1[11]) + in3, b3 = (s1[12] + s1[13]) + (s1[14] + s1[15]) + s1[11];
                tw[(0 + 2 * hi) * 32] = a0; tw[(1 + 2 * hi) * 32] = b0; tw[(4 + 2 * hi) * 32] = a1; tw[(5 + 2 * hi) * 32] = b1;
                tw[(8 + 2 * hi) * 32] = a2; tw[(9 + 2 * hi) * 32] = b2; tw[(12 + 2 * hi) * 32] = a3; tw[(13 + 2 * hi) * 32] = b3;
                if (hi) tw[16 * 32] = c3;
            }
            pv_tile(Vt, s0, s1, o0, o1, lane);
        ATT_LOOP_END(NTC, false)
        {
            const LAS float* tp_ = (const LAS float*)(L + AL_TMP) + ((NTC - 1) & 1) * (8 * 17 * 32);
            for (int e = tid; e < 2 * 17 * 32; e += 512) { const int q32 = e & 31, jl = (e >> 5) % 17, qh = e / (17 * 32);
                const float a = (tp_[((qh * 4 + 0) * 17 + jl) * 32 + q32] + tp_[((qh * 4 + 1) * 17 + jl) * 32 + q32]) + (tp_[((qh * 4 + 2) * 17 + jl) * 32 + q32] + tp_[((qh * 4 + 3) * 17 + jl) * 32 + q32]);
                psl[((NTC - 1) * 16 + jl) * PSL_P + qh * 32 + q32] += a; }
            __syncthreads();
        }
        float* prow = PART + row * 512 + head * 64;
#pragma unroll
        for (int g4 = 0; g4 < 4; ++g4) {
            *(f32x4*)(prow + 8 * g4 + 4 * hi) = (f32x4){o0[4 * g4] * gc, o0[4 * g4 + 1] * gc, o0[4 * g4 + 2] * gc, o0[4 * g4 + 3] * gc};
            *(f32x4*)(prow + 32 + 8 * g4 + 4 * hi) = (f32x4){o1[4 * g4] * gc, o1[4 * g4 + 1] * gc, o1[4 * g4 + 2] * gc, o1[4 * g4 + 3] * gc};
        }
    }
    for (int rp_ = 0; rp_ < ((PROBE_SUB & 2) ? 2 : 1); ++rp_)
    {
        const int cur = qb;
        const int nforced = cur == 0 ? 1 : (cur == 1 ? 2 : 3);
        const int ncand = max(0, cur - 2), K = min(16, cur + 1) - nforced;
        const unsigned long long lt_mask = (1ull << lane) - 1ull;
        for (int qq = 0; qq < 8; ++qq) {
            const int q = wid * 8 + qq; const int tq = qb * 64 + q;
            unsigned key[4]; bool cand[4], selb[4];
#pragma unroll
            for (int ii = 0; ii < 4; ++ii) { const int j = lane + 64 * ii; key[ii] = __float_as_uint(psl[j * PSL_P + q]);
                cand[ii] = (j >= 1) && (j <= cur - 2); selb[ii] = (j == 0) || (j == cur) || (j == cur - 1); }
            if (K >= ncand) {
#pragma unroll
                for (int ii = 0; ii < 4; ++ii) selb[ii] = selb[ii] || cand[ii];
            } else {
                unsigned tau = 0u;
                for (int bit = 30; bit >= 0; --bit) {
                    const unsigned trial = tau | (1u << bit);
                    int cnt = 0;
#pragma unroll
                    for (int ii = 0; ii < 4; ++ii) cnt += __popcll(__ballot(cand[ii] && key[ii] >= trial));
                    if (cnt == K) { tau = trial - 1u; break; }
                    if (cnt > K) tau = trial;
                }
                int cgt = 0;
#pragma unroll
                for (int ii = 0; ii < 4; ++ii) cgt += __popcll(__ballot(cand[ii] && key[ii] > tau));
                int need = K - cgt;
#pragma unroll
                for (int ii = 0; ii < 4; ++ii) {
                    const bool eq = cand[ii] && key[ii] == tau;
                    const unsigned long long bal = __ballot(eq);
                    const int rank = __popcll(bal & lt_mask);
                    selb[ii] = selb[ii] || (cand[ii] && key[ii] > tau) || (eq && rank < need);
                    need = max(0, need - (int)__popcll(bal));
                }
            }
            LAS unsigned* mrow = (LAS unsigned*)(L + AL_SM) + q * 8; (void)tq;
#pragma unroll
            for (int ii = 0; ii < 4; ++ii) { const unsigned long long bal = __ballot(selb[ii]); if (lane == 0) { mrow[2 * ii] = (unsigned)bal; mrow[2 * ii + 1] = (unsigned)(bal >> 32); } }
        }
    }
    for (int rp_ = 0; rp_ < ((PROBE_SUB & 4) ? 2 : 1); ++rp_)
    {
        f32x16 o0, o1;
#pragma unroll
        for (int r = 0; r < 16; ++r) { o0[r] = 0.f; o1[r] = 0.f; }
        RowState rs; rs.mref = 0.f; rs.l = 0.f; rs.seen = false;
        const int jw0 = max(0, qb - 8), NTW = qb - jw0 + 1;
        const bf16_t* kb_ = PROJ + (size_t)(b * SEQ) * PROJ_LD + 1664 + g * 64; const size_t kpitch_ = PROJ_LD;
        const bf16_t* vb_ = VT + (size_t)((b * 12 + 10 + g) * 64) * SEQ; const size_t vpitch_ = SEQ;
        ATT_LOOP_BEGIN(NTW, false, kb_ + (size_t)((jw0 + jt) * 64) * PROJ_LD, vb_ + (size_t)(jw0 + jt) * 64, (const float*)nullptr)
            const int kv0 = (jw0 + jt) * 64;
            TP tp; tp.cs = nullptr; tp.sl = sl; tp.fb = sl * (float)(kv0 + 8 * hi - t); tp.lim = t - kv0 - 8 * hi; tp.lim2 = tp.lim - 512; tp.sel = true;
            const bool full = (kv0 + 63 <= tq0) && (tq0 + 31 - kv0 < 512);
            attn_tile<1>(Kt, Vt, qf, o0, o1, rs, tp, !full, lane);
        ATT_LOOP_END(NTW, false)
        float l = rs.l; l += __shfl_xor(l, 32);
        const float sc = gwn / fmaxf(l, 1e-30f);
        float* prow = PART + row * 512 + head * 64;
        if ((PROBE_SUB & 4) && rp_ == 0) continue;
#pragma unroll
        for (int g4 = 0; g4 < 4; ++g4) {
            f32x4 a = *(f32x4*)(prow + 8 * g4 + 4 * hi), c = *(f32x4*)(prow + 32 + 8 * g4 + 4 * hi);
            a = a + (f32x4){o0[4 * g4] * sc, o0[4 * g4 + 1] * sc, o0[4 * g4 + 2] * sc, o0[4 * g4 + 3] * sc};
            c = c + (f32x4){o1[4 * g4] * sc, o1[4 * g4 + 1] * sc, o1[4 * g4 + 2] * sc, o1[4 * g4 + 3] * sc};
            *(f32x4*)(prow + 8 * g4 + 4 * hi) = a; *(f32x4*)(prow + 32 + 8 * g4 + 4 * hi) = c;
        }
    }
}

DI void slc_unit(const Params& P, lptr L, int u, int tid, int lane, int wid) {
    unsigned char* ws = P.ws;
    const bf16_t* PROJ = (const bf16_t*)(ws + WS_PROJ); const bf16_t* VT = (const bf16_t*)(ws + WS_VT);
    const float* PART = (const float*)(ws + WS_PART); bf16_t* ATT = (bf16_t*)(ws + WS_U);
    const int bg = u & 3, b = bg >> 1, g = bg & 1, qb = 255 - (u >> 2);
    const int r4 = wid & 3, qs = wid >> 2, i = lane & 31, hi = lane >> 5;
    const int head = g * 4 + r4, tq0 = qb * 64 + qs * 32, t = tq0 + i, ql = qs * 32 + i;
    const size_t row = (size_t)b * SEQ + t;
    const float slope = exp2f(-(float)(head + 1)), sl = slope * L2E;
    LAS unsigned* sm = (LAS unsigned*)(L + AL_SM);
    LAS unsigned* un = (LAS unsigned*)(L + AL_MISC);
    LAS unsigned char* list = (LAS unsigned char*)(L + AL_LIST);
    if (tid < 16) un[tid] = 0u;
    __syncthreads();
    { const unsigned w = sm[tid]; if (w) __hip_atomic_fetch_or(un + (tid & 7), w, __ATOMIC_RELAXED, __HIP_MEMORY_SCOPE_WORKGROUP); }
    __syncthreads();
    if (tid < 256) {
        const unsigned w = un[tid >> 5];
        if ((w >> (tid & 31)) & 1u) {
            int pos = __popc(w & ((1u << (tid & 31)) - 1u));
            for (int k = 0; k < (tid >> 5); ++k) pos += __popc(un[k]);
            list[pos] = (unsigned char)tid;
        }
    }
    int NTS = 0;
#pragma unroll
    for (int k = 0; k < 8; ++k) NTS += __popc(un[k]);
    __syncthreads();
    bf16x8 qf[4]; load_q(qf, PROJ + row * PROJ_LD + 1024 + head * 64, hi);
    const float gs = sigmoid_f(bf2f(PROJ[row * PROJ_LD + 1792 + head * 3 + 1]));
    f32x16 o0, o1;
#pragma unroll
    for (int r = 0; r < 16; ++r) { o0[r] = 0.f; o1[r] = 0.f; }
    RowState rs; rs.mref = 0.f; rs.l = 0.f; rs.seen = false;
    const bf16_t* kb_ = PROJ + (size_t)(b * SEQ) * PROJ_LD + 1536 + g * 64; const size_t kpitch_ = PROJ_LD;
    const bf16_t* vb_ = VT + (size_t)((b * 12 + 8 + g) * 64) * SEQ; const size_t vpitch_ = SEQ;
    ATT_LOOP_BEGIN(NTS, false, kb_ + (size_t)((int)list[jt] * 64) * PROJ_LD, vb_ + (size_t)((int)list[jt]) * 64, (const float*)nullptr)
        const int j = (int)list[jt], kv0 = j * 64;
        const bool sel = (sm[ql * 8 + (j >> 5)] >> (j & 31)) & 1u;
        if (__any(sel)) {
            TP tp; tp.cs = nullptr; tp.sl = sl; tp.fb = sl * (float)(kv0 + 8 * hi - t); tp.lim = t - kv0 - 8 * hi; tp.lim2 = -(1 << 30); tp.sel = sel;
            attn_tile<1>(Kt, Vt, qf, o0, o1, rs, tp, true, lane);
        }
    ATT_LOOP_END(NTS, false)
    float l = rs.l; l += __shfl_xor(l, 32);
    const float sc = gs / fmaxf(l, 1e-30f);
    const float* prow = PART + row * 512 + head * 64;
    bf16_t* orow = ATT + row * DM + 512 + head * 64;
#pragma unroll
    for (int g4 = 0; g4 < 4; ++g4) {
        const f32x4 a = *(const f32x4*)(prow + 8 * g4 + 4 * hi), c = *(const f32x4*)(prow + 32 + 8 * g4 + 4 * hi);
        u32x2 w0, w1;
        w0.x = pk_bf16(a[0] + o0[4 * g4] * sc, a[1] + o0[4 * g4 + 1] * sc); w0.y = pk_bf16(a[2] + o0[4 * g4 + 2] * sc, a[3] + o0[4 * g4 + 3] * sc);
        w1.x = pk_bf16(c[0] + o1[4 * g4] * sc, c[1] + o1[4 * g4 + 1] * sc); w1.y = pk_bf16(c[2] + o1[4 * g4 + 2] * sc, c[3] + o1[4 * g4 + 3] * sc);
        *(u32x2*)(orow + 8 * g4 + 4 * hi) = w0; *(u32x2*)(orow + 32 + 8 * g4 + 4 * hi) = w1;
    }
}

template <bool IN16, bool OUT16, int NB>
DI void rowwise_phase(const void* hin, const bf16_t* mo, const float* gA, void* hout, const float* gB, bf16_t* uout, float* rstd_out, int gw, int NGW, int lane) {
    for (int row0 = NB * gw; row0 < MT; row0 += NB * NGW) {
        u32x2 mw[NB][4]; u32x2 hw[NB][4]; f32x4 hx[NB][4];
#pragma unroll
        for (int b = 0; b < NB; ++b) {
            const int row = row0 + b;
#pragma unroll
            for (int jj = 0; jj < 4; ++jj) {
                mw[b][jj] = ((const u32x2*)(mo + (size_t)row * DM) + lane)[64 * jj];
                if (IN16) hw[b][jj] = ((const u32x2*)((const bf16_t*)hin + (size_t)row * DM) + lane)[64 * jj];
                else hx[b][jj] = ((const f32x4*)((const float*)hin + (size_t)row * DM) + lane)[64 * jj];
            }
        }
#pragma unroll
        for (int b = 0; b < NB; ++b) {
            const int row = row0 + b;
            f32x4 mv[4], hv[4]; float ss = 0.f;
#pragma unroll
            for (int jj = 0; jj < 4; ++jj) { const u32x2 m2 = mw[b][jj]; mv[jj] = (f32x4){bflo(m2.x), bfhi(m2.x), bflo(m2.y), bfhi(m2.y)};
                if (IN16) { const u32x2 h2 = hw[b][jj]; hv[jj] = (f32x4){bflo(h2.x), bfhi(h2.x), bflo(h2.y), bfhi(h2.y)}; } else hv[jj] = hx[b][jj];
                ss += (mv[jj].x * mv[jj].x + mv[jj].y * mv[jj].y) + (mv[jj].z * mv[jj].z + mv[jj].w * mv[jj].w); }
            const float rstd = 1.f / sqrtf(wave_sum(ss) * (1.f / DM) + RMS_EPS);
            float s2 = 0.f;
#pragma unroll
            for (int jj = 0; jj < 4; ++jj) { const f32x4 ga = *((const f32x4*)gA + lane + 64 * jj); hv[jj] = hv[jj] + mv[jj] * rstd * ga;
                if (OUT16) { u32x2 w; w.x = pk_bf16(hv[jj].x, hv[jj].y); w.y = pk_bf16(hv[jj].z, hv[jj].w); ((u32x2*)((bf16_t*)hout + (size_t)row * DM) + lane)[64 * jj] = w; }
                else ((f32x4*)((float*)hout + (size_t)row * DM) + lane)[64 * jj] = hv[jj];
                s2 += (hv[jj].x * hv[jj].x + hv[jj].y * hv[jj].y) + (hv[jj].z * hv[jj].z + hv[jj].w * hv[jj].w); }
            if (rstd_out) { const float rstd2 = 1.f / sqrtf(wave_sum(s2) * (1.f / DM) + RMS_EPS); if (lane == 0) rstd_out[row] = rstd2; }
            if (uout) {
                const float rstd2 = 1.f / sqrtf(wave_sum(s2) * (1.f / DM) + RMS_EPS);
                u32x2* uo = (u32x2*)(uout + (size_t)row * DM) + lane;
#pragma unroll
                for (int jj = 0; jj < 4; ++jj) { const f32x4 gb = *((const f32x4*)gB + lane + 64 * jj); const f32x4 y = hv[jj] * rstd2 * gb;
                    u32x2 w; w.x = pk_bf16(y.x, y.y); w.y = pk_bf16(y.z, y.w); uo[64 * jj] = w; }
            }
        }
    }
}
DI float log_sigmoid_f(float z) { return fminf(z, 0.f) - log1pf(__expf(-fabsf(z))); }

DI void p0_row(const Params& P, int row, const f32x4 (&v)[4], bf16_t* U, float* LOGF, const LAS f32x4* wf, int lane) {
    float ss = 0.f;
#pragma unroll
    for (int jj = 0; jj < 4; ++jj) { ss += (v[jj].x * v[jj].x + v[jj].y * v[jj].y) + (v[jj].z * v[jj].z + v[jj].w * v[jj].w); }
    const float rstd = 1.f / sqrtf(wave_sum(ss) * (1.f / DM) + RMS_EPS);
    u32x2* uo = (u32x2*)(U + (size_t)row * DM) + lane;
    float acc[8];
#pragma unroll
    for (int j = 0; j < 8; ++j) acc[j] = 0.f;
#pragma unroll
    for (int jj = 0; jj < 4; ++jj) { const f32x4 g0 = *((const f32x4*)P.norm_g + lane + 64 * jj); const f32x4 y = v[jj] * rstd * g0;
        u32x2 w; w.x = pk_bf16(y.x, y.y); w.y = pk_bf16(y.z, y.w); uo[64 * jj] = w;
#pragma unroll
        for (int e = 0; e < 4; ++e) { const f32x4 wa = wf[((jj * 4 + e) * 2 + 0) * 64 + lane], wb = wf[((jj * 4 + e) * 2 + 1) * 64 + lane]; const float ye = y[e];
            acc[0] += ye * wa.x; acc[1] += ye * wa.y; acc[2] += ye * wa.z; acc[3] += ye * wa.w; acc[4] += ye * wb.x; acc[5] += ye * wb.y; acc[6] += ye * wb.z; acc[7] += ye * wb.w; } }
    float mine = 0.f;
#pragma unroll
    for (int j = 0; j < 8; ++j) { const float s = wave_sum(acc[j]); if (lane == j) mine = s; }
    if (lane < 8) { const int b = row >> 14, t = row & (SEQ - 1); LOGF[(size_t)(b * 8 + lane) * SEQ + t] = log_sigmoid_f(mine + P.b_f[lane]); }
}

DI bool seg_late(int s) { return s >= 11 && s != 16 && s != 17; }
DI int transposes_total(bool late) { int total = 0; for (int s = 0; s < NSEG; ++s) if (seg_late(s) == late) total += (SEGS[s].K / 64) * ((SEGS[s].len + 31) / 32); return total; }
DI void transpose_by_index(const Params& P, unsigned char* ws, LAS float* scr, int idx, bool late, int lane) {
    int rem = idx, s = 0;
    for (; s < NSEG; ++s) { if (seg_late(s) != late) continue; const int n = (SEGS[s].K / 64) * ((SEGS[s].len + 31) / 32); if (rem < n) break; rem -= n; }
    const Seg sg = SEGS[s]; const int nnb = (sg.len + 31) / 32;
    const float* W = (sg.inp == 2 ? P.w_in : sg.inp == 7 ? P.w_out : sg.inp == 8 ? P.pool_w : sg.inp == 5 ? P.cmp_w1 : sg.inp == 10 ? P.w_gate : sg.inp == 11 ? P.w_up : P.w_down) + sg.srcoff;
    transpose_item(W, sg.ldw, sg.src0, sg.len, (bf16_t*)(ws + (size_t)sg.dstoff_kb * 1024), sg.ldwt, sg.dst0, sg.dstride, sg.scoff >= 0 ? P.pool_scale + sg.scoff : (const float*)nullptr, sg.gkoff >= 0 ? P.norm_g + sg.gkoff : (const float*)nullptr, scr, rem / nnb, rem % nnb, lane);
}

#define XB_TMO      128
#define XB_XCNT(j)  (256  + 64 * (j))
#define XB_XSUB(j)  (1280 + 64 * (j))
#define XB_XGEN(j)  (2304 + 64 * (j))
#define XB_TOP      3328
#define XB_TOPGEN   3392
#define XCD_BAR_WORDS 3456
#define XB_SPIN_CAP (1u << 18)

__device__ __forceinline__ unsigned xb_ld(unsigned* p)              { return __hip_atomic_load(p, __ATOMIC_RELAXED, __HIP_MEMORY_SCOPE_AGENT); }
__device__ __forceinline__ unsigned xb_add(unsigned* p, unsigned v) { return __hip_atomic_fetch_add(p, v, __ATOMIC_RELAXED, __HIP_MEMORY_SCOPE_AGENT); }
__device__ __forceinline__ unsigned xb_xcc_id() { return (unsigned)__builtin_amdgcn_s_getreg((3 << 11) | 20) & 0xFu; }
#define XB_SPIN(cond, bar) do { unsigned _sp = 0; while (cond) { __builtin_amdgcn_s_sleep(1); \
    if ((++_sp & 255u) == 0u) { if (xb_ld(&(bar)[XB_TMO])) break; if (_sp > XB_SPIN_CAP) { atomicAdd(&(bar)[XB_TMO], 1u); break; } } } } while (0)

struct XcdBarrier {
    unsigned* bar; unsigned x;
    volatile LAS unsigned* st;
};

__device__ __forceinline__ XcdBarrier xcd_barrier_post(unsigned* bar, volatile LAS unsigned* st) {
    XcdBarrier b; b.bar = bar; b.x = xb_xcc_id(); b.st = st;
    if (threadIdx.x == 0) (void)xb_add(&bar[XB_XCNT(b.x)], 1u);
    return b;
}
__device__ __forceinline__ void xcd_barrier_complete(unsigned* bar, unsigned x, unsigned& nloc, unsigned& nx) {
    const unsigned G = gridDim.x * gridDim.y * gridDim.z;
    unsigned sum, cnt, mine, sp = 0u;
    for (;;) {
        sum = 0u; cnt = 0u; mine = 0u;
#pragma unroll
        for (unsigned j = 0; j < 16; ++j) { const unsigned c = xb_ld(&bar[XB_XCNT(j)]); sum += c; cnt += (c > 0u) ? 1u : 0u; mine = (j == x) ? c : mine; }
        if (sum == G) break;
        __builtin_amdgcn_s_sleep(1);
        if ((++sp & 255u) == 0u) { if (xb_ld(&bar[XB_TMO])) break; if (sp > XB_SPIN_CAP) { atomicAdd(&bar[XB_TMO], 1u); break; } }
    }
    nloc = mine > 0u ? mine : 1u; nx = cnt > 0u ? cnt : 1u;
}

__device__ __forceinline__ void xcd_barrier(const XcdBarrier& b) {
    asm volatile("s_waitcnt vmcnt(0)" ::: "memory");
    __syncthreads();
    if (threadIdx.x == 0) {
        unsigned* bar = b.bar;
        __builtin_amdgcn_s_waitcnt(0);
        unsigned nloc = b.st[0], nx = b.st[1];
        if (nloc == 0u) { xcd_barrier_complete(bar, b.x, nloc, nx); b.st[0] = nloc; b.st[1] = nx; }
        const unsigned old = xb_add(&bar[XB_XSUB(b.x)], 1u);
        const unsigned gen = old / nloc;
        if (old + 1u == (gen + 1u) * nloc) {
            __builtin_amdgcn_fence(__ATOMIC_RELEASE, "agent");
            asm volatile("s_waitcnt vmcnt(0)" ::: "memory");
            const unsigned og = xb_add(&bar[XB_TOP], 1u);
            const unsigned tg = og / nx;
            if (og + 1u == (tg + 1u) * nx) xb_add(&bar[XB_TOPGEN], 1u);
            else XB_SPIN(xb_ld(&bar[XB_TOPGEN]) == tg, bar);
            __builtin_amdgcn_fence(__ATOMIC_ACQUIRE, "agent");
            xb_add(&bar[XB_XGEN(b.x)], 1u);
            asm volatile("s_waitcnt vmcnt(0)" ::: "memory");
        } else {
            XB_SPIN(xb_ld(&bar[XB_XGEN(b.x)]) == gen, bar);
            __builtin_amdgcn_fence(__ATOMIC_ACQUIRE, "agent");
            asm volatile("s_waitcnt vmcnt(0)" ::: "memory");
        }
    }
    __syncthreads();
}

struct RoundOrder {
    pg8::StaticOrder so; int round;
    __device__ __forceinline__ bool next(int i, pg8::Unit& u) const { return i == 0 ? so.next(round, u) : false; }
    __device__ __forceinline__ void a_ready(const pg8::Unit&) const {}
    __device__ __forceinline__ void done(const pg8::Unit&) const {}
};
template <bool IN16, bool OUT16>
struct EpiResFused {
    static constexpr bool PERM = true, AFTER_DRAIN = true;
    const void* hin; void* hout; const float* gA; float* ssqm; float* ssqh; unsigned* pcnt;
    __device__ __forceinline__ void fused(f32x4 (&acc)[2][2][4][2], const pg8::Unit& u, int wr, int wc, int fr, int fq, PG8_LAS unsigned char* lds, int wid, int lane) const {
        LAS float* red = (LAS float*)lds;
        const int tid = wid * 64 + lane;
#pragma unroll
        for (int ai = 0; ai < 2; ++ai)
#pragma unroll
            for (int m = 0; m < 4; ++m) {
                float s = 0.f;
#pragma unroll
                for (int bj = 0; bj < 2; ++bj)
#pragma unroll
                    for (int n = 0; n < 2; ++n) { const f32x4 x = acc[ai][bj][m][n]; s += (x[0] * x[0] + x[1] * x[1]) + (x[2] * x[2] + x[3] * x[3]); }
                s += __shfl_xor(s, 16); s += __shfl_xor(s, 32);
                if (fq == 0) red[(ai * 128 + wr * 64 + m * 16 + fr) * 4 + wc] = s;
            }
        __syncthreads();
        if (tid < 256) atomicAdd(ssqm + u.pm * 256 + tid, (red[tid * 4] + red[tid * 4 + 1]) + (red[tid * 4 + 2] + red[tid * 4 + 3]));
        asm volatile("s_waitcnt vmcnt(0)" ::: "memory");
        __syncthreads();
        if (tid == 0) { atomicAdd(pcnt + u.pm, 1u); while (__hip_atomic_load(pcnt + u.pm, __ATOMIC_RELAXED, __HIP_MEMORY_SCOPE_AGENT) < 4u) __builtin_amdgcn_s_sleep(2); }
        __syncthreads();
        const int colb = u.pn * 256 + wc * 32 + 8 * fq;
        f32x4 gv[2][2];
#pragma unroll
        for (int bj = 0; bj < 2; ++bj)
#pragma unroll
            for (int n = 0; n < 2; ++n) gv[bj][n] = *(const f32x4*)(gA + colb + bj * 128 + 4 * n);
#pragma unroll
        for (int ai = 0; ai < 2; ++ai)
#pragma unroll
            for (int m = 0; m < 4; ++m) {
                const int rl = ai * 128 + wr * 64 + m * 16 + fr; const size_t row = (size_t)u.pm * 256 + rl;
                const float rm = 1.f / sqrtf(__hip_atomic_load(ssqm + row, __ATOMIC_RELAXED, __HIP_MEMORY_SCOPE_AGENT) * (1.f / DM) + RMS_EPS);
                float sh = 0.f;
#pragma unroll
                for (int bj = 0; bj < 2; ++bj) {
                    const size_t off = row * DM + colb + bj * 128;
                    f32x4 h0, h1;
                    if (IN16) { const u32x4 hw = *(const u32x4*)((const bf16_t*)hin + off); h0 = (f32x4){bflo(hw.x), bfhi(hw.x), bflo(hw.y), bfhi(hw.y)}; h1 = (f32x4){bflo(hw.z), bfhi(hw.z), bflo(hw.w), bfhi(hw.w)}; }
                    else { h0 = *(const f32x4*)((const float*)hin + off); h1 = *(const f32x4*)((const float*)hin + off + 4); }
                    h0 = h0 + acc[ai][bj][m][0] * rm * gv[bj][0]; h1 = h1 + acc[ai][bj][m][1] * rm * gv[bj][1];
                    sh += ((h0[0] * h0[0] + h0[1] * h0[1]) + (h0[2] * h0[2] + h0[3] * h0[3])) + ((h1[0] * h1[0] + h1[1] * h1[1]) + (h1[2] * h1[2] + h1[3] * h1[3]));
                    if (OUT16) { u32x4 w; w.x = pk_bf16(h0[0], h0[1]); w.y = pk_bf16(h0[2], h0[3]); w.z = pk_bf16(h1[0], h1[1]); w.w = pk_bf16(h1[2], h1[3]); *(u32x4*)((bf16_t*)hout + off) = w; }
                    else { *(f32x4*)((float*)hout + off) = h0; *(f32x4*)((float*)hout + off + 4) = h1; }
                }
                if (ssqh) { sh += __shfl_xor(sh, 16); sh += __shfl_xor(sh, 32); if (fq == 0) red[rl * 4 + wc] = sh; }
            }
        if (ssqh) { __syncthreads(); if (tid < 256) atomicAdd(ssqh + u.pm * 256 + tid, (red[tid * 4] + red[tid * 4 + 1]) + (red[tid * 4 + 2] + red[tid * 4 + 3])); }
        __syncthreads();
    }
};
#define FUSED_GEMM(IN16, OUT16, GEMM, HIN, HOUT, GA, SSQM, SSQH, PH) { \
        EpiResFused<IN16, OUT16> E{(HIN), (HOUT), (GA), (SSQM), (SSQH), CTL + CW_PANEL + (PH) * 128}; \
        { RoundOrder S; S.so.init(MT, DM, G, bx); S.round = 0; pg8::gemm_phase<EpiResFused<IN16, OUT16>, RoundOrder, false, true>((PG8_LAS unsigned char*)lds_raw, (GEMM), S, E); } \
        { RoundOrder S; S.so.init(MT, DM, G, bx); S.round = 1; pg8::gemm_phase<EpiResFused<IN16, OUT16>, RoundOrder, false, true>((PG8_LAS unsigned char*)lds_raw, (GEMM), S, E); } }

constexpr int LDS_BYTES = 147456;
static_assert(AL_END <= LDS_BYTES - 64, "attention LDS map");
constexpr int NPH = 17;

__global__ void __launch_bounds__(512) fwd_kernel(Params P) {
    extern __shared__ __attribute__((aligned(16))) unsigned char lds_raw[];
    cg::grid_group grid = cg::this_grid();
    lptr L = (lptr)lds_raw;
    const int tid = threadIdx.x, lane = tid & 63, wid = __builtin_amdgcn_readfirstlane(tid >> 6);
    const int G = gridDim.x, bx = blockIdx.x, gw = bx * 8 + wid, NGW = G * 8;
    unsigned char* ws = P.ws;
    unsigned* CTL = (unsigned*)(ws + WS_CTL);
    bf16_t* U = (bf16_t*)(ws + WS_U);
    bf16_t* MOUT = (bf16_t*)(ws + WS_MOUT);
    float* SSQ = (float*)(ws + WS_SMASK);
    const int lo = P.ph_lo, hi_ = P.ph_hi;
    volatile LAS unsigned* bst_ = (volatile LAS unsigned*)(L + LDS_BYTES - 64);
    if (tid < 2) bst_[tid] = 0u;
    __syncthreads();
    const XcdBarrier xbar_ = xcd_barrier_post(CTL + CW_BAR + P.bar_region * XCD_BAR_WORDS, bst_);
    if (P.ph_hi < 0) grid.sync();
#define IN(k) (lo <= (k) && (k) < hi_)
#define SEAM(k) do { if (IN(k) && IN((k) + 1)) xcd_barrier(xbar_); } while (0)
#ifdef PROBE_DBL
#define REP_BEGIN(k) for (int rep_ = 0; rep_ < (((PROBE_DBL >> (k)) & 1) ? 2 : 1); ++rep_) {
#define REP_END(k) if (((PROBE_DBL >> (k)) & 1) && rep_ == 0) grid.sync(); }
#define REPQ (rep_ * 16)
#else
#define REP_BEGIN(k) {
#define REP_END(k) }
#define REPQ 0
#endif

    if (IN(0)) { REP_BEGIN(0)
        LAS f32x4* wf = (LAS f32x4*)(L + 71680);
        for (int f = tid; f < 2048; f += 512) { const int ln = f & 63, jq = (f >> 6) & 1, e = (f >> 7) & 3, jj = f >> 9, k = 4 * ln + e + 256 * jj;
            wf[f] = *(const f32x4*)(P.w_in + (size_t)k * INC + 1536 + 4 * jq); }
        __syncthreads();
        LAS float* scr = (LAS float*)(L + wid * 8448);
        { const int total = transposes_total(false); for (int idx = gw; idx < total; idx += NGW) transpose_by_index(P, ws, scr, idx, false, lane); }
        float* cbias = (float*)(ws + WS_CBIAS);
        for (int idx = gw; idx < 128; idx += NGW) { const int which = idx >> 6, j = idx & 63; float a = 0.f;
            for (int k = lane; k < 2048; k += 64) a += P.cmp_pe[which * 2048 + k] * P.cmp_w1[(size_t)(which * 2048 + k) * 64 + j];
            a = wave_sum(a); if (lane == 0) cbias[idx] = a; }
        float* LOGF = (float*)(ws + WS_LOGF);
        for (int e = bx * 512 + tid; e < 7 * MT / 4; e += G * 512) ((f32x4*)SSQ)[e] = (f32x4){0.f, 0.f, 0.f, 0.f};
        for (int row0 = 4 * gw; row0 < MT; row0 += 4 * NGW) {
            f32x4 xv[4][4];
#pragma unroll
            for (int b = 0; b < 4; ++b)
#pragma unroll
                for (int jj = 0; jj < 4; ++jj) xv[b][jj] = ((const f32x4*)(P.x + (size_t)(row0 + b) * DM) + lane)[64 * jj];
#pragma unroll
            for (int b = 0; b < 4; ++b) p0_row(P, row0 + b, xv[b], U, LOGF, wf, lane);
        }
        __syncthreads();
    REP_END(0) }
    SEAM(0);
    if (IN(1)) { REP_BEGIN(1)
        pg8::Gemm g{U, (const bf16_t*)(ws + WS_WIN_T), MT, NPROJ, DM, DM, DM, 0, 30}; pg8::StaticOrder S; S.init(MT, NPROJ, G, bx);
        pg8::EpiInProj E{(bf16_t*)(ws + WS_PROJ), (bf16_t*)(ws + WS_VT), (bf16_t*)(ws + WS_CMPIN)};
        pg8::gemm_phase<pg8::EpiInProj, pg8::StaticOrder, true, true>((PG8_LAS unsigned char*)lds_raw, g, S, E);
    REP_END(1) }
    SEAM(1);
    if (IN(2)) {
        pg8::Gemm g{(const bf16_t*)(ws + WS_CMPIN), (const bf16_t*)(ws + WS_W1_T), 8192, 2048, 256, 1024, 2048, 512, 4, 0, 512}; pg8::StaticOrder S; S.init(8192, 2048, G, bx);
        pg8::EpiCompress E{(float*)(ws + WS_HIDP)};
        pg8::gemm_phase<pg8::EpiCompress, pg8::StaticOrder, true, true>((PG8_LAS unsigned char*)lds_raw, g, S, E);
        if (bx < 16) {
            const float* src = (const float*)(ws + WS_LOGF) + (size_t)bx * SEQ + tid * 32; float* dst = (float*)(ws + WS_C) + (size_t)bx * SEQ + tid * 32;
            float v[32];
#pragma unroll
            for (int q = 0; q < 8; ++q) { const f32x4 x4 = *((const f32x4*)src + q); v[4 * q] = x4.x; v[4 * q + 1] = x4.y; v[4 * q + 2] = x4.z; v[4 * q + 3] = x4.w; }
            float run = 0.f;
#pragma unroll
            for (int q = 0; q < 32; ++q) { run += v[q]; v[q] = run; }
            float inc = run;
#pragma unroll
            for (int o = 1; o < 64; o <<= 1) { const float y = __shfl_up(inc, o); if (lane >= o) inc += y; }
            LAS float* wt = (LAS float*)(L + AL_MISC);
            if (lane == 63) wt[wid] = inc;
            __syncthreads();
            float base = inc - run;
            for (int w = 0; w < wid; ++w) base += wt[w];
#pragma unroll
            for (int q = 0; q < 8; ++q) *((f32x4*)dst + q) = (f32x4){v[4 * q] + base, v[4 * q + 1] + base, v[4 * q + 2] + base, v[4 * q + 3] + base};
            __syncthreads();
        }
        const bf16_t* PROJ = (const bf16_t*)(ws + WS_PROJ);
        for (int ch = gw; ch < MT / 16; ch += NGW) {
            float mx = 0.f;
            for (int rr = 0; rr < 16; ++rr) { const int row = ch * 16 + rr;
                const u32x4 a = *(const u32x4*)(PROJ + (size_t)row * PROJ_LD + 16 * lane), c = *(const u32x4*)(PROJ + (size_t)row * PROJ_LD + 16 * lane + 8);
                float ss = 0.f;
#pragma unroll
                for (int e = 0; e < 4; ++e) { const float a0 = bflo(a[e]), a1 = bfhi(a[e]), c0 = bflo(c[e]), c1 = bfhi(c[e]); ss += a0 * a0 + a1 * a1 + c0 * c0 + c1 * c1; }
                ss += __shfl_xor(ss, 1); ss += __shfl_xor(ss, 2);
                mx = fmaxf(mx, ss); }
            if ((lane & 3) == 0) atomicMax(CTL + CW_NRM + ((ch * 16) >> 14) * 16 + (lane >> 2), __float_as_uint(mx));
        }
    }
    SEAM(2);
    if (IN(3)) { REP_BEGIN(3)
        volatile LAS int* qs_ = (volatile LAS int*)(L + AL_MISC + 256);
        bool pp_seen = false;
        for (;;) {
            __syncthreads();
            if (tid == 0) qs_[0] = (int)atomicAdd(CTL + CW_Q3 + REPQ, 1u);
            __syncthreads();
            const int u = qs_[0];
            const int nlate = transposes_total(true), nlate_wg = (nlate + 7) >> 3;
            if (u >= 128 + 2048 + nlate_wg) break;
            if (u >= 128 + 2048) {
                const int idx = (u - (128 + 2048)) * 8 + wid;
                if (idx < nlate) transpose_by_index(P, ws, (LAS float*)(L + 40960 + wid * 8448), idx, true, lane);
                continue;
            }
            if (u < 128) {
                const int which = u >> 6; const float* w2 = P.cmp_w2 + which * 4096;
                float wcol[64];
#pragma unroll
                for (int i2 = 0; i2 < 64; ++i2) wcol[i2] = w2[i2 * 64 + lane];
                const float* HIDP = (const float*)(ws + WS_HIDP); bf16_t* KC = (bf16_t*)(ws + WS_KC); bf16_t* VCT = (bf16_t*)(ws + WS_VCT);
                const float cb = ((const float*)(ws + WS_CBIAS))[which * 64 + lane];
                for (int rr = 0; rr < 8; ++rr) { const int ridx = u * 64 + wid * 8 + rr; const int n = ridx & 1023, bgi = (ridx >> 10) & 3;
                    float hs = cb;
#pragma unroll
                    for (int ks = 0; ks < 8; ++ks) hs += HIDP[((size_t)ks * 8192 + ridx) * 64 + lane];
                    const float hv = pg8::gelu_tanh_f(hs); float o = 0.f;
#pragma unroll
                    for (int i2 = 0; i2 < 64; ++i2) o += __shfl(hv, i2) * wcol[i2];
                    if (n == 1023) o = 0.f;
                    const bf16_t ob = (bf16_t)(pk_bf16(o, 0.f) & 0xffffu);
                    if (which == 0) KC[((size_t)bgi * 1024 + n) * 64 + lane] = ob; else VCT[((size_t)bgi * 64 + lane) * 1024 + n] = ob; }
                asm volatile("s_waitcnt vmcnt(0)" ::: "memory");
                __syncthreads();
                if (tid == 0) { __threadfence(); atomicAdd(CTL + CW_PPDONE + REPQ, 1u); }
            } else {
                const int v = u - 128;
                if (v & 1) fox_unit(P, L, v >> 1, tid, lane, wid);
                else {
                    if (!pp_seen) {
                        if (tid == 0) { while (__hip_atomic_load(CTL + CW_PPDONE + REPQ, __ATOMIC_RELAXED, __HIP_MEMORY_SCOPE_AGENT) < 128u) __builtin_amdgcn_s_sleep(8); }
                        __syncthreads();
                        __builtin_amdgcn_fence(__ATOMIC_ACQUIRE, "agent");
                        pp_seen = true;
                    }
                    cmpwin_unit(P, L, v >> 1, tid, lane, wid);
                    slc_unit(P, L, v >> 1, tid, lane, wid);
                }
            }
        }
    REP_END(3) }
    SEAM(3);
    if (IN(6)) { REP_BEGIN(6)
        pg8::Gemm g{U, (const bf16_t*)(ws + WS_WOUT_T), MT, DM, DM, DM, DM, 0, 30};
        FUSED_GEMM(false, true, g, P.x, ws + WS_H16, P.norm_g + 1 * DM, SSQ + 0 * (size_t)MT, SSQ + 1 * (size_t)MT, 0)
    REP_END(6) }
    SEAM(6);
        if (IN(8)) { REP_BEGIN(8)
            pg8::Gemm g{(const bf16_t*)(ws + WS_H16), (const bf16_t*)(ws + WS_GU_T + 0 * GU_T_STRIDE), MT, 2 * FFH, DM, DM, DM, 0, 30}; pg8::StaticOrder S; S.init(MT, 2 * FFH, G, bx);
            pg8::EpiSwiGLU E{(bf16_t*)(ws + WS_HID), SSQ + 1 * (size_t)MT};
            pg8::gemm_phase<pg8::EpiSwiGLU, pg8::StaticOrder, true, true>((PG8_LAS unsigned char*)lds_raw, g, S, E);
        REP_END(8) }
        SEAM(8);
        if (IN(9)) { REP_BEGIN(9)
            pg8::Gemm g{(const bf16_t*)(ws + WS_HID), (const bf16_t*)(ws + WS_DN_T + 0 * DN_T_STRIDE), MT, DM, FFH, FFH, FFH, 0, 30};
            FUSED_GEMM(true, true, g, ws + WS_H16, ws + WS_H16, P.norm_g + 3 * DM, SSQ + 2 * (size_t)MT, SSQ + 3 * (size_t)MT, 1)
        REP_END(9) }
        SEAM(9);
            if (IN(11)) { REP_BEGIN(11)
                bf16_t* POOLED = (bf16_t*)(ws + WS_POOLED); const bf16_t* H16 = (const bf16_t*)(ws + WS_H16);
                for (int item = bx * 512 + tid; item < 131072; item += G * 512) {
                    const int c0 = (item & 127) * 8, run = item >> 7, row0 = run * 32, t0 = row0 & (SEQ - 1), w = 2 << (c0 >> 8);
                    float sum[8];
#pragma unroll
                    for (int e = 0; e < 8; ++e) sum[e] = 0.f;
                    for (int i2 = 1; i2 < w; ++i2) if (t0 - i2 >= 0) { const u32x4 a = *(const u32x4*)(H16 + (size_t)(row0 - i2) * DM + c0); const float r = 1.f / sqrtf(SSQ[3 * (size_t)MT + row0 - i2] * (1.f / DM) + RMS_EPS);
#pragma unroll
                        for (int e = 0; e < 4; ++e) { sum[2 * e] += bflo(a[e]) * r; sum[2 * e + 1] += bfhi(a[e]) * r; } }
                    for (int tb = 0; tb < 32; tb += 8) {
                        u32x4 cn[8], co[8]; float rn[8], ro[8];
#pragma unroll
                        for (int k = 0; k < 8; ++k) { const int tt = tb + k, t = t0 + tt; const bool old = (tt > 0 && t - w >= 0);
                            cn[k] = *(const u32x4*)(H16 + (size_t)(row0 + tt) * DM + c0); rn[k] = 1.f / sqrtf(SSQ[3 * (size_t)MT + row0 + tt] * (1.f / DM) + RMS_EPS);
                            co[k] = old ? *(const u32x4*)(H16 + (size_t)(row0 + tt - w) * DM + c0) : (u32x4){0u, 0u, 0u, 0u}; ro[k] = old ? 1.f / sqrtf(SSQ[3 * (size_t)MT + row0 + tt - w] * (1.f / DM) + RMS_EPS) : 0.f; }
#pragma unroll
                        for (int k = 0; k < 8; ++k) { const int tt = tb + k, t = t0 + tt;
                            const float rc = 1.f / (float)min(t + 1, w); u32x4 o;
#pragma unroll
                            for (int e = 0; e < 4; ++e) { const float x0 = bflo(cn[k][e]) * rn[k], x1 = bfhi(cn[k][e]) * rn[k];
                                sum[2 * e] += x0 - bflo(co[k][e]) * ro[k]; sum[2 * e + 1] += x1 - bfhi(co[k][e]) * ro[k];
                                o[e] = pk_bf16(sum[2 * e] * rc - x0, sum[2 * e + 1] * rc - x1); }
                            *(u32x4*)(POOLED + (size_t)(row0 + tt) * DM + c0) = o; }
                    }
                }
            REP_END(11) }
            SEAM(11);
            if (IN(12)) { REP_BEGIN(12)
                pg8::Gemm g{(const bf16_t*)(ws + WS_POOLED), (const bf16_t*)(ws + WS_POOL_T), MT, DM, 256, DM, 256, 512, 30};
                FUSED_GEMM(true, true, g, ws + WS_H16, ws + WS_H16, P.norm_g + 5 * DM, SSQ + 4 * (size_t)MT, SSQ + 5 * (size_t)MT, 2)
            REP_END(12) }
            SEAM(12);
        if (IN(14)) {
            pg8::Gemm g{(const bf16_t*)(ws + WS_H16), (const bf16_t*)(ws + WS_GU_T + 1 * GU_T_STRIDE), MT, 2 * FFH, DM, DM, DM, 0, 30}; pg8::StaticOrder S; S.init(MT, 2 * FFH, G, bx);
            pg8::EpiSwiGLU E{(bf16_t*)(ws + WS_HID), SSQ + 5 * (size_t)MT};
            pg8::gemm_phase<pg8::EpiSwiGLU, pg8::StaticOrder, true, true>((PG8_LAS unsigned char*)lds_raw, g, S, E);
        }
        SEAM(14);
        if (IN(15)) {
            pg8::Gemm g{(const bf16_t*)(ws + WS_HID), (const bf16_t*)(ws + WS_DN_T + 1 * DN_T_STRIDE), MT, DM, FFH, FFH, FFH, 0, 30};
            FUSED_GEMM(true, false, g, ws + WS_H16, P.out, P.norm_g + 7 * DM, SSQ + 6 * (size_t)MT, (float*)nullptr, 3)
        }
#undef IN
#undef SEAM
}

#ifndef N_LAUNCHES
#define N_LAUNCHES 1
#endif
extern "C" void kernel_launch(void* const* d_in, const int* in_sizes, int n_in, void* d_out, int out_size, void* d_ws, size_t ws_size, hipStream_t stream) {
    static int grid = 0;
    if (grid == 0) {
        if (n_in != 13 || in_sizes[0] != MT * DM || out_size != MT * DM || ws_size < WS_END) { fprintf(stderr, "kernel_launch: unexpected shapes / workspace (%d inputs, ws %zu)\n", n_in, ws_size); grid = -1; return; }
        int dev = 0, cus = 0, per_cu = 0;
        hipGetDevice(&dev); hipDeviceGetAttribute(&cus, hipDeviceAttributeMultiprocessorCount, dev);
        if (hipFuncSetAttribute((const void*)fwd_kernel, hipFuncAttributeMaxDynamicSharedMemorySize, LDS_BYTES) != hipSuccess) { fprintf(stderr, "kernel_launch: hipFuncSetAttribute failed\n"); grid = -1; return; }
        if (hipOccupancyMaxActiveBlocksPerMultiprocessor(&per_cu, (const void*)fwd_kernel, 512, LDS_BYTES) != hipSuccess || per_cu < 1) { fprintf(stderr, "kernel_launch: occupancy query says %d\n", per_cu); per_cu = 1; }
        (void)hipGetLastError();
        grid = cus * 1;
        if (grid != 256) { fprintf(stderr, "kernel_launch: built for a 256-CU device (one 256x256 GEMM unit per workgroup per round); got %d\n", grid); grid = -1; return; }
    }
    if (grid < 0) return;
    hipMemsetAsync((char*)d_ws + WS_CTL, 0, CTL_BYTES, stream);
    Params p{};
    p.x = (const float*)d_in[0]; p.norm_g = (const float*)d_in[1]; p.w_in = (const float*)d_in[2]; p.b_f = (const float*)d_in[3]; p.cmp_pe = (const float*)d_in[4];
    p.cmp_w1 = (const float*)d_in[5]; p.cmp_w2 = (const float*)d_in[6]; p.w_out = (const float*)d_in[7]; p.pool_w = (const float*)d_in[8]; p.pool_scale = (const float*)d_in[9];
    p.w_gate = (const float*)d_in[10]; p.w_up = (const float*)d_in[11]; p.w_down = (const float*)d_in[12];
    p.out = (float*)d_out; p.ws = (unsigned char*)d_ws;
#if defined(PROBE_PH)
    { Params pa = p, pb = p; pa.ph_lo = 0; pa.ph_hi = PROBE_PH + 1; pa.bar_region = 0; pb.ph_lo = PROBE_PH; pb.ph_hi = NPH; pb.bar_region = 1;
      void* a1[] = {&pa}; void* a2[] = {&pb};
      hipLaunchCooperativeKernel((const void*)fwd_kernel, dim3(grid), dim3(512), a1, LDS_BYTES, stream);
      hipLaunchCooperativeKernel((const void*)fwd_kernel, dim3(grid), dim3(512), a2, LDS_BYTES, stream); }
#elif N_LAUNCHES == 1
    p.ph_lo = 0; p.ph_hi = NPH;
    void* args[] = {&p};
    hipError_t e = hipLaunchCooperativeKernel((const void*)fwd_kernel, dim3(grid), dim3(512), args, LDS_BYTES, stream);
    if (e != hipSuccess) fprintf(stderr, "cooperative launch failed: %s (grid %d)\n", hipGetErrorString(e), grid);
#else
    for (int ph = 0; ph < NPH; ++ph) { p.ph_lo = ph; p.ph_hi = ph + 1; hipLaunchKernelGGL(fwd_kernel, dim3(grid), dim3(512), LDS_BYTES, stream, p); }
#endif
}
```

```cpp
#include <hip/hip_runtime.h>
#include <hip/hip_cooperative_groups.h>
#include <cstdio>
#include <cstdint>
namespace cg = cooperative_groups;
#ifndef PROBE_SUB
#define PROBE_SUB 0
#endif

#define DI __device__ __forceinline__
#define LAS __attribute__((address_space(3)))
typedef LAS char* lptr;
typedef unsigned short bf16_t;
typedef short bf16x8 __attribute__((ext_vector_type(8)));
typedef float f32x4 __attribute__((ext_vector_type(4)));
typedef float f32x2 __attribute__((ext_vector_type(2)));
typedef float f32x16 __attribute__((ext_vector_type(16)));
typedef unsigned u32x4 __attribute__((ext_vector_type(4)));
typedef unsigned u32x2 __attribute__((ext_vector_type(2)));
typedef __bf16 bf16x2_t __attribute__((ext_vector_type(2)));

DI unsigned pk_bf16(float lo, float hi) { f32x2 v = {lo, hi}; bf16x2_t b = __builtin_convertvector(v, bf16x2_t); return __builtin_bit_cast(unsigned, b); }
DI float bf2f(bf16_t v) { return __uint_as_float(((unsigned)v) << 16); }
DI float bflo(unsigned w) { return __uint_as_float(w << 16); }
DI float bfhi(unsigned w) { return __uint_as_float(w & 0xffff0000u); }

namespace pg8 {
#define PG8_LAS __attribute__((address_space(3)))
constexpr int BM = 256, BK = 64, HALF = 128, HTB = HALF * BK * 2, STAGE_BYTES = 8 * HTB, NXCD = 8, WGM = 8;
__host__ __device__ __forceinline__ int lds_byte(int r, int c) { const int st = (r >> 4) * 2 + (c >> 5), rr = r & 15, cc = c & 31, ob = rr * 64 + cc * 2; return st * 1024 + (ob ^ (((ob >> 9) & 1) << 5)); }
__host__ __device__ __forceinline__ void stage_rc(int b, int& R, int& C) { const int st = b / 1024, sb = b % 1024, swz = sb ^ (((sb >> 9) & 1) << 5); R = (st >> 1) * 16 + swz / 64; C = (st & 1) * 32 + (swz % 64) / 2; }
__host__ __device__ __forceinline__ int perm32(int rho) { const int n = rho >> 4, i = rho & 15; return 8 * (i >> 2) + 4 * n + (i & 3); }
struct Unit { int pm, pn; };
struct Gemm { const bf16_t* A; const bf16_t* Bt; int M, N, K, lda, ldb, a_pn_bytes, bsel_shift; int b_pn_rows = 1, b_pn_bytes = 0; };
struct StaticOrder {
    int nM, nN, nwg, G, c;
    __host__ __device__ void init(int M, int N, int G_, int c_) { nM = M / BM; nN = N / BM; nwg = nM * nN; G = G_; c = c_; }
    __host__ __device__ bool next(int i, Unit& u) const {
        const long L = (long)i * G + c; if (L >= nwg) return false;
        int wgid = (int)L; { const int q = nwg / NXCD, r = nwg % NXCD, xcd = wgid % NXCD, off = wgid / NXCD; wgid = (xcd < r ? xcd * (q + 1) : r * (q + 1) + (xcd - r) * q) + off; }
        const int nig = WGM * nN, gid = wgid / nig, fm = gid * WGM, gsz = (nM - fm) < WGM ? (nM - fm) : WGM;
        u.pm = fm + ((wgid % nig) % gsz); u.pn = (wgid % nig) / gsz; return true;
    }
    __device__ __forceinline__ void a_ready(const Unit&) const {}
    __device__ __forceinline__ void done(const Unit&) const {}
};
template <class Epi, class Sched, bool ALIGN_EPI = false, bool SP2 = false>
__device__ __forceinline__ void gemm_phase(PG8_LAS unsigned char* lds, const Gemm g, const Sched& S, const Epi& E) {
    const int tid = threadIdx.x, wid = __builtin_amdgcn_readfirstlane(tid >> 6), lane = tid & 63, wr = wid >> 2, wc = wid & 3, fr = lane & 15, fq = lane >> 4;
    const int K = g.K, nt = K / BK;
    unsigned voffA[2], voffB[2];
#pragma unroll
    for (int i = 0; i < 2; ++i) { int R, C; stage_rc(tid * 16 + i * 8192, R, C); const int Rb = Epi::PERM ? ((R & ~31) + perm32(R & 31)) : R;
        voffA[i] = (unsigned)(R * g.lda + C) * 2u; voffB[i] = (unsigned)(Rb * g.ldb + C) * 2u; }
    const size_t kstep = (size_t)(BK * 2);
    const size_t hstepA = (size_t)HALF * g.lda * 2, hstepB = (size_t)HALF * g.ldb * 2;
    const size_t tstepA = 2 * hstepA, tstepB = 2 * hstepB;
    const unsigned ldsw = (unsigned)wid * 1024u;
    const int aoff = lds_byte(wr * 64 + fr, fq * 8), boff = lds_byte(wc * 32 + fr, fq * 8);
#define PG8_UA(u) ((const char*)g.A + (size_t)(u).pm * tstepA + (size_t)(u).pn * (size_t)g.a_pn_bytes)
#define PG8_UB(u) ((const char*)g.Bt + (size_t)((u).pn * g.b_pn_rows + ((u).pm >> g.bsel_shift)) * tstepB + (size_t)(u).pn * (size_t)g.b_pn_bytes)
#define PG8_SA(b, h) (((b) * 2 + (h)) * HTB)
#define PG8_SB(b, h) ((4 + (b) * 2 + (h)) * HTB)
#define PG8_STAGE(bufoff, gbase, voff) do { _Pragma("unroll") for (int _i = 0; _i < 2; ++_i) \
        __builtin_amdgcn_global_load_lds((const unsigned*)((const char*)(gbase) + (voff)[_i]), (PG8_LAS unsigned*)(lds + (bufoff) + ldsw + _i * 8192), 16, 0, 0); } while (0)
#define PG8_LDA(dst, b, h) do { _Pragma("unroll") for (int m = 0; m < 4; ++m) _Pragma("unroll") for (int k = 0; k < 2; ++k) dst[m][k] = *(const PG8_LAS bf16x8*)(lds + PG8_SA(b, h) + aoff + m * 2048 + k * 1024); } while (0)
#define PG8_LDB(dst, b, h) do { _Pragma("unroll") for (int n = 0; n < 2; ++n) _Pragma("unroll") for (int k = 0; k < 2; ++k) dst[n][k] = *(const PG8_LAS bf16x8*)(lds + PG8_SB(b, h) + boff + n * 2048 + k * 1024); } while (0)
#define PG8_MMA(ai, bj, At, Bt) do { __builtin_amdgcn_s_setprio(1); _Pragma("unroll") for (int m = 0; m < 4; ++m) _Pragma("unroll") for (int n = 0; n < 2; ++n) _Pragma("unroll") for (int k = 0; k < 2; ++k) \
        acc[ai][bj][m][n] = __builtin_amdgcn_mfma_f32_16x16x32_bf16(Bt[n][k], At[m][k], acc[ai][bj][m][n], 0, 0, 0); __builtin_amdgcn_s_setprio(0); } while (0)
#define PG8_WAIT_V(n) asm volatile("s_waitcnt vmcnt(" #n ")" ::: "memory")
#define PG8_WAIT_L(n) asm volatile("s_waitcnt lgkmcnt(" #n ")" ::: "memory")
#define PG8_BAR __builtin_amdgcn_s_barrier()
#define PG8_SCHED __builtin_amdgcn_sched_barrier(0)
    Unit cur, nxt; int ui = 0;
    if (!S.next(0, cur)) return;
    f32x4 acc[2][2][4][2];
#pragma unroll
    for (int a = 0; a < 2; ++a)
#pragma unroll
        for (int b = 0; b < 2; ++b)
#pragma unroll
            for (int m = 0; m < 4; ++m)
#pragma unroll
                for (int n = 0; n < 2; ++n) acc[a][b][m][n] = (f32x4){0.f, 0.f, 0.f, 0.f};
    bf16x8 At[4][2], B0[2][2], B1[2][2];
    const char* cA = PG8_UA(cur); const char* cB = PG8_UB(cur);
    S.a_ready(cur);
    if constexpr (SP2) {
        PG8_STAGE(PG8_SB(0, 0), cB, voffB); PG8_STAGE(PG8_SB(0, 1), cB + hstepB, voffB); PG8_STAGE(PG8_SA(0, 0), cA, voffA); PG8_STAGE(PG8_SA(0, 1), cA + hstepA, voffA);
        if (wr == 1) PG8_BAR;
        PG8_WAIT_V(2); PG8_BAR;
        PG8_STAGE(PG8_SB(1, 0), cB + kstep, voffB); PG8_STAGE(PG8_SA(1, 0), cA + kstep, voffA); PG8_STAGE(PG8_SB(1, 1), cB + hstepB + kstep, voffB);
        PG8_WAIT_V(6); PG8_BAR;
    } else {
        PG8_STAGE(PG8_SB(0, 0), cB, voffB); PG8_STAGE(PG8_SA(0, 0), cA, voffA); PG8_STAGE(PG8_SB(0, 1), cB + hstepB, voffB); PG8_STAGE(PG8_SA(0, 1), cA + hstepA, voffA);
        if (wr == 1) PG8_BAR;
        PG8_WAIT_V(4); PG8_BAR;
        PG8_STAGE(PG8_SB(1, 0), cB + kstep, voffB); PG8_STAGE(PG8_SA(1, 0), cA + kstep, voffA); PG8_STAGE(PG8_SB(1, 1), cB + hstepB + kstep, voffB);
        PG8_WAIT_V(6); PG8_BAR;
    }
    for (;;) {
        const bool has_next = S.next(ui + 1, nxt);
        const char* nA = has_next ? PG8_UA(nxt) : cA; const char* nB = has_next ? PG8_UB(nxt) : cB;
        for (int t = 0; t < nt; t += 2) {
            const bool last = (t == nt - 2);
            const char* a1 = cA + (size_t)(t + 1) * kstep;
            const char* a2 = last ? nA : cA + (size_t)(t + 2) * kstep; const char* b2 = last ? nB : cB + (size_t)(t + 2) * kstep;
            const char* a3 = a2 + kstep; const char* b3 = b2 + kstep;
            if (last && has_next) S.a_ready(nxt);
            if constexpr (SP2) {
            PG8_LDB(B0, 0, 0); PG8_LDB(B1, 0, 1); PG8_SCHED; PG8_LDA(At, 0, 0); PG8_STAGE(PG8_SA(1, 1), a1 + hstepA, voffA);
            PG8_WAIT_V(8); PG8_WAIT_L(0); PG8_BAR; PG8_MMA(0, 0, At, B0); PG8_MMA(0, 1, At, B1); PG8_BAR; PG8_SCHED;
            PG8_LDA(At, 0, 1); PG8_STAGE(PG8_SB(0, 0), b2, voffB); PG8_STAGE(PG8_SB(0, 1), b2 + hstepB, voffB); PG8_STAGE(PG8_SA(0, 0), a2, voffA);
            PG8_WAIT_V(8); PG8_WAIT_L(0); PG8_BAR; PG8_MMA(1, 0, At, B0); PG8_MMA(1, 1, At, B1); PG8_BAR; PG8_SCHED;
            PG8_LDB(B0, 1, 0); PG8_LDB(B1, 1, 1); PG8_SCHED; PG8_LDA(At, 1, 0); PG8_STAGE(PG8_SA(0, 1), a2 + hstepA, voffA);
            PG8_WAIT_V(8); PG8_WAIT_L(0); PG8_BAR; PG8_MMA(0, 0, At, B0); PG8_MMA(0, 1, At, B1); PG8_BAR; PG8_SCHED;
            PG8_LDA(At, 1, 1); PG8_STAGE(PG8_SB(1, 0), b3, voffB); PG8_STAGE(PG8_SB(1, 1), b3 + hstepB, voffB); PG8_STAGE(PG8_SA(1, 0), a3, voffA);
            PG8_WAIT_V(8); PG8_WAIT_L(0); PG8_BAR; PG8_MMA(1, 0, At, B0); PG8_MMA(1, 1, At, B1); PG8_BAR; PG8_SCHED;
            } else {
            PG8_LDB(B0, 0, 0); PG8_SCHED; PG8_LDA(At, 0, 0); PG8_STAGE(PG8_SA(1, 1), a1 + hstepA, voffA);
            PG8_WAIT_L(8); PG8_BAR; PG8_WAIT_L(0); PG8_MMA(0, 0, At, B0); PG8_BAR; PG8_SCHED;
            PG8_LDB(B1, 0, 1); PG8_STAGE(PG8_SB(0, 0), b2, voffB);
            PG8_BAR; PG8_WAIT_L(0); PG8_MMA(0, 1, At, B1); PG8_BAR;
            PG8_LDA(At, 0, 1); PG8_STAGE(PG8_SA(0, 0), a2, voffA);
            PG8_BAR; PG8_WAIT_L(0); PG8_MMA(1, 0, At, B0); PG8_BAR; PG8_SCHED;
            PG8_STAGE(PG8_SB(0, 1), b2 + hstepB, voffB);
            PG8_WAIT_V(6); PG8_BAR; PG8_MMA(1, 1, At, B1); PG8_BAR;
            PG8_LDB(B0, 1, 0); PG8_SCHED; PG8_LDA(At, 1, 0); PG8_STAGE(PG8_SA(0, 1), a2 + hstepA, voffA);
            PG8_WAIT_L(8); PG8_BAR; PG8_WAIT_L(0); PG8_MMA(0, 0, At, B0); PG8_BAR; PG8_SCHED;
            PG8_LDB(B1, 1, 1); PG8_STAGE(PG8_SB(1, 0), b3, voffB);
            PG8_BAR; PG8_WAIT_L(0); PG8_MMA(0, 1, At, B1); PG8_BAR;
            PG8_LDA(At, 1, 1); PG8_STAGE(PG8_SA(1, 0), a3, voffA);
            PG8_BAR; PG8_WAIT_L(0); PG8_MMA(1, 0, At, B0); PG8_BAR; PG8_SCHED;
            PG8_STAGE(PG8_SB(1, 1), b3 + hstepB, voffB);
            PG8_WAIT_V(6); PG8_BAR; PG8_MMA(1, 1, At, B1); PG8_BAR;
            }
        }
        if constexpr (ALIGN_EPI) { if (wr == 0) PG8_BAR; }
        if constexpr (!Epi::AFTER_DRAIN) { E(acc, cur, wr, wc, fr, fq); S.done(cur); }
        if (!has_next) break;
#pragma unroll
        for (int a = 0; a < 2; ++a)
#pragma unroll
            for (int b = 0; b < 2; ++b)
#pragma unroll
                for (int m = 0; m < 4; ++m)
#pragma unroll
                    for (int n = 0; n < 2; ++n) acc[a][b][m][n] = (f32x4){0.f, 0.f, 0.f, 0.f};
        cur = nxt; cA = nA; cB = nB; ++ui;
        if constexpr (ALIGN_EPI) { if (wr == 1) PG8_BAR; }
    }
    PG8_WAIT_V(0);
    if constexpr (!ALIGN_EPI) { if (wr == 0) PG8_BAR; }
    PG8_BAR;
    if constexpr (Epi::AFTER_DRAIN) { E.fused(acc, cur, wr, wc, fr, fq, lds, wid, lane); S.done(cur); }
#undef PG8_SA
#undef PG8_UA
#undef PG8_UB
#undef PG8_SB
#undef PG8_STAGE
#undef PG8_LDA
#undef PG8_LDB
#undef PG8_MMA
#undef PG8_WAIT_V
#undef PG8_WAIT_L
#undef PG8_BAR
#undef PG8_SCHED
}
}

constexpr int BATCH = 2, SEQ = 16384, DM = 1024, MT = BATCH * SEQ, FFH = 2816, INC = 2848;
constexpr int PROJ_LD = 2112;
constexpr int VTP = SEQ + 64;
constexpr int NPROJ = 3072;
constexpr float L2E = 1.4426950408889634f;
constexpr float C2 = 0.125f * L2E;
constexpr float RMS_EPS = 1e-6f;
constexpr size_t MiB = 1u << 20;
constexpr size_t WS_CTL = 0, CTL_BYTES = 65536;
constexpr size_t WS_WIN_T = 1 * MiB, WS_WOUT_T = 7 * MiB, WS_POOL_T = 9 * MiB, WS_W1_T = 10 * MiB;
constexpr size_t WS_GU_T = 12 * MiB, GU_T_STRIDE = 12 * MiB, WS_DN_T = 36 * MiB, DN_T_STRIDE = 6 * MiB;
constexpr size_t WS_LOGF = 48 * MiB, WS_C = 49 * MiB, WS_CBIAS = 50 * MiB, WS_KC = 50 * MiB + 65536, WS_VCT = 51 * MiB, WS_SMASK = 52 * MiB, WS_HIDC = 54 * MiB;
constexpr size_t WS_U = 56 * MiB;
constexpr size_t WS_PROJ = 120 * MiB;
constexpr size_t WS_VT = WS_PROJ + 133 * MiB;
constexpr size_t WS_HID = WS_PROJ, WS_POOLED = WS_PROJ;
constexpr size_t WS_CMPIN = 303 * MiB;
constexpr size_t WS_MOUT = 322 * MiB;
constexpr size_t WS_PART = WS_MOUT;
constexpr size_t WS_HIDP = 388 * MiB;
constexpr size_t WS_H16 = 442 * MiB;
constexpr size_t WS_END = 506 * MiB;
constexpr int CW_Q3 = 0, CW_Q4 = 64, CW_Q5 = 128, CW_NRM = 192, CW_PPDONE = 320, CW_BAR = 1024, CW_PANEL = 12288;

struct Params {
    const float* x; const float* norm_g; const float* w_in; const float* b_f; const float* cmp_pe; const float* cmp_w1; const float* cmp_w2;
    const float* w_out; const float* pool_w; const float* pool_scale; const float* w_gate; const float* w_up; const float* w_down;
    float* out; unsigned char* ws; int ph_lo, ph_hi, bar_region, pad_;
};

namespace pg8 {
__device__ __forceinline__ unsigned cvt_pk_bf16(float lo, float hi) { return pk_bf16(lo, hi); }
#define EPI_ROWS_BEGIN \
    _Pragma("unroll") for (int ai = 0; ai < 2; ++ai) _Pragma("unroll") for (int m = 0; m < 4; ++m) { const int row = u.pm * BM + ai * HALF + wr * 64 + m * 16 + fr; \
    _Pragma("unroll") for (int bj = 0; bj < 2; ++bj) { const int colt = bj * HALF + wc * 32 + 8 * fq; const f32x4 v0 = acc[ai][bj][m][0], v1 = acc[ai][bj][m][1];
#define EPI_ROWS_END } }

struct EpiInProj {
    static constexpr bool PERM = true, AFTER_DRAIN = false;
    bf16_t* proj; bf16_t* vt; bf16_t* cmpin;
    __device__ __forceinline__ void operator()(const f32x4 (&acc)[2][2][4][2], const Unit& u, int wr, int wc, int fr, int fq) const {
        const int pn = u.pn;
        if (pn < 8) {
            const float qsc = (pn < 2 || pn == 4 || pn == 5) ? C2 : 1.f;
            EPI_ROWS_BEGIN
                u32x4 w; w.x = cvt_pk_bf16(v0[0] * qsc, v0[1] * qsc); w.y = cvt_pk_bf16(v0[2] * qsc, v0[3] * qsc); w.z = cvt_pk_bf16(v1[0] * qsc, v1[1] * qsc); w.w = cvt_pk_bf16(v1[2] * qsc, v1[3] * qsc);
                *(u32x4*)(proj + (size_t)row * PROJ_LD + pn * 256 + colt) = w;
            EPI_ROWS_END
        } else if (pn < 11) {
            EPI_ROWS_BEGIN
                const int cc = (pn - 8) * 256 + colt, vh = cc >> 6, d = cc & 63, b = row >> 14, t = row & (SEQ - 1);
                bf16_t* dst = vt + ((size_t)(b * 12 + vh) * 64 + d) * VTP + t;
                const unsigned w0 = cvt_pk_bf16(v0[0], v0[1]), w1 = cvt_pk_bf16(v0[2], v0[3]), w2 = cvt_pk_bf16(v1[0], v1[1]), w3 = cvt_pk_bf16(v1[2], v1[3]);
                dst[0 * (size_t)VTP] = (bf16_t)(w0 & 0xffffu); dst[1 * (size_t)VTP] = (bf16_t)(w0 >> 16);
                dst[2 * (size_t)VTP] = (bf16_t)(w1 & 0xffffu); dst[3 * (size_t)VTP] = (bf16_t)(w1 >> 16);
                dst[4 * (size_t)VTP] = (bf16_t)(w2 & 0xffffu); dst[5 * (size_t)VTP] = (bf16_t)(w2 >> 16);
                dst[6 * (size_t)VTP] = (bf16_t)(w3 & 0xffffu); dst[7 * (size_t)VTP] = (bf16_t)(w3 >> 16);
            EPI_ROWS_END
        } else {
            EPI_ROWS_BEGIN
                const int which = colt >> 7, g = (colt >> 6) & 1, d = colt & 63, b = row >> 14, t = row & (SEQ - 1);
                u32x4 w; w.x = cvt_pk_bf16(v0[0], v0[1]); w.y = cvt_pk_bf16(v0[2], v0[3]); w.z = cvt_pk_bf16(v1[0], v1[1]); w.w = cvt_pk_bf16(v1[2], v1[3]);
                *(u32x4*)(cmpin + ((size_t)((which * 2 + b) * 2 + g) * SEQ + t) * 64 + d) = w;
            EPI_ROWS_END
        }
    }
};
struct EpiBf16M {
    static constexpr bool PERM = true, AFTER_DRAIN = false;
    bf16_t* out; int ldc;
    __device__ __forceinline__ void operator()(const f32x4 (&acc)[2][2][4][2], const Unit& u, int wr, int wc, int fr, int fq) const {
        EPI_ROWS_BEGIN
            u32x4 w; w.x = cvt_pk_bf16(v0[0], v0[1]); w.y = cvt_pk_bf16(v0[2], v0[3]); w.z = cvt_pk_bf16(v1[0], v1[1]); w.w = cvt_pk_bf16(v1[2], v1[3]);
            *(u32x4*)(out + (size_t)row * ldc + u.pn * BM + colt) = w;
        EPI_ROWS_END
    }
};
struct EpiF32 {
    static constexpr bool PERM = true, AFTER_DRAIN = false;
    float* out; int ldc; const float* cscale;
    __device__ __forceinline__ void operator()(const f32x4 (&acc)[2][2][4][2], const Unit& u, int wr, int wc, int fr, int fq) const {
        EPI_ROWS_BEGIN
            const int col = u.pn * BM + colt; f32x4 a = v0, b = v1;
            if (cscale) { a = a * *(const f32x4*)(cscale + col); b = b * *(const f32x4*)(cscale + col + 4); }
            float* p = out + (size_t)row * ldc + col; *(f32x4*)p = a; *(f32x4*)(p + 4) = b;
        EPI_ROWS_END
    }
};
__device__ __forceinline__ float silu_f(float x) { return x * __builtin_amdgcn_rcpf(1.f + __builtin_amdgcn_exp2f(-x * L2E)); }
struct EpiSwiGLU {
    static constexpr bool PERM = true, AFTER_DRAIN = false;
    bf16_t* hid; const float* rstd;
    __device__ __forceinline__ void operator()(const f32x4 (&acc)[2][2][4][2], const Unit& u, int wr, int wc, int fr, int fq) const {
        EPI_ROWS_BEGIN
            const int hc = (u.pn * BM + colt) >> 1; const float r = 1.f / sqrtf(rstd[row] * (1.f / DM) + RMS_EPS);
            const float h0 = silu_f(v0[0] * r) * (v0[1] * r), h1 = silu_f(v0[2] * r) * (v0[3] * r), h2 = silu_f(v1[0] * r) * (v1[1] * r), h3 = silu_f(v1[2] * r) * (v1[3] * r);
            u32x2 w; w.x = cvt_pk_bf16(h0, h1); w.y = cvt_pk_bf16(h2, h3);
            *(u32x2*)(hid + (size_t)row * FFH + hc) = w;
        EPI_ROWS_END
    }
};
__device__ __forceinline__ float gelu_tanh_f(float x) {
    const float y = 0.7978845608028654f * (x + 0.044715f * x * x * x);
    const float e = __expf(2.f * y);
    const float th = 1.f - 2.f / (1.f + e);
    return 0.5f * x * (1.f + th);
}
struct EpiCompress {
    static constexpr bool PERM = true, AFTER_DRAIN = false;
    float* hidp;
    __device__ __forceinline__ void operator()(const f32x4 (&acc)[2][2][4][2], const Unit& u, int wr, int wc, int fr, int fq) const {
        EPI_ROWS_BEGIN
            if (colt < 64) { float* p = hidp + ((size_t)u.pn * 8192 + row) * 64 + colt; *(f32x4*)p = v0; *(f32x4*)(p + 4) = v1; }
        EPI_ROWS_END
    }
};
}

DI float wave_sum(float v) {
#pragma unroll
    for (int o = 1; o < 64; o <<= 1) v += __shfl_xor(v, o);
    return v;
}
DI float exp2_fast(float x) { return __builtin_amdgcn_exp2f(x); }

struct Seg { int inp; int srcoff; int ldw; int K; int src0; int len; int dstoff_kb; int ldwt; int dst0; int dstride; int scoff; int gkoff; };
#define SEG_IN(src0, len, dst0) {2, 0, INC, 1024, src0, len, (int)(WS_WIN_T / 1024), 1024, dst0, 1, -1, -1}
__constant__ Seg SEGS[] = {
    SEG_IN(0, 512, 0), SEG_IN(512, 512, 512), SEG_IN(1544, 512, 1024), SEG_IN(2312, 128, 1536), SEG_IN(2568, 128, 1664), SEG_IN(2824, 24, 1792),
    SEG_IN(1024, 512, 2048), SEG_IN(2440, 128, 2560), SEG_IN(2696, 128, 2688), SEG_IN(2056, 128, 2816), SEG_IN(2184, 128, 2944),
    {7, 0, 1024, 1024, 0, 1024, (int)(WS_WOUT_T / 1024), 1024, 0, 1, -1, -1},
    {8, 0 * 65536, 256, 256, 0, 256, (int)(WS_POOL_T / 1024), 256, 0, 1, 0, 4 * DM + 0}, {8, 1 * 65536, 256, 256, 0, 256, (int)(WS_POOL_T / 1024), 256, 256, 1, 256, 4 * DM + 256},
    {8, 2 * 65536, 256, 256, 0, 256, (int)(WS_POOL_T / 1024), 256, 512, 1, 512, 4 * DM + 512}, {8, 3 * 65536, 256, 256, 0, 256, (int)(WS_POOL_T / 1024), 256, 768, 1, 768, 4 * DM + 768},
    {5, 0, 64, 2048, 0, 64, (int)(WS_W1_T / 1024), 2048, 0, 1, -1, -1}, {5, 2048 * 64, 64, 2048, 0, 64, (int)(WS_W1_T / 1024), 2048, 256, 1, -1, -1},
    {10, 0, FFH, 1024, 0, FFH, (int)(WS_GU_T / 1024), 1024, 0, 2, -1, 2 * DM}, {11, 0, FFH, 1024, 0, FFH, (int)(WS_GU_T / 1024), 1024, 1, 2, -1, 2 * DM},
    {10, 1024 * FFH, FFH, 1024, 0, FFH, (int)((WS_GU_T + GU_T_STRIDE) / 1024), 1024, 0, 2, -1, 6 * DM}, {11, 1024 * FFH, FFH, 1024, 0, FFH, (int)((WS_GU_T + GU_T_STRIDE) / 1024), 1024, 1, 2, -1, 6 * DM},
    {12, 0, 1024, FFH, 0, 1024, (int)(WS_DN_T / 1024), FFH, 0, 1, -1, -1}, {12, FFH * 1024, 1024, FFH, 0, 1024, (int)((WS_DN_T + DN_T_STRIDE) / 1024), FFH, 0, 1, -1, -1},
};
constexpr int NSEG = 24;

DI void transpose_item(const float* W, int ldw, int src0, int len, bf16_t* WT, int ldwt, int dst0, int dstride, const float* csc, const float* gk, LAS float* scr, int kb, int nb, int lane) {
    const int k0 = 64 * kb, n0 = 32 * nb;
    const bool okc = (n0 + (lane & 31)) < len;
    const float cs_ = (csc && okc) ? csc[n0 + (lane & 31)] : 1.f;
    float tv[32];
#pragma unroll
    for (int i = 0; i < 32; ++i) { const int kk = 2 * i + (lane >> 5); tv[i] = okc ? W[(size_t)(k0 + kk) * ldw + src0 + n0 + (lane & 31)] : 0.f; }
#pragma unroll
    for (int i = 0; i < 32; ++i) { const int kk = 2 * i + (lane >> 5); scr[kk * 33 + (lane & 31)] = tv[i] * cs_ * (gk ? gk[k0 + kk] : 1.f); }
    asm volatile("s_waitcnt lgkmcnt(0)" ::: "memory");
    const int c = lane & 7;
#pragma unroll
    for (int j = 0; j < 4; ++j) { const int n = (lane >> 3) + 8 * j; const LAS float* s = scr + (8 * c) * 33 + n;
        u32x4 o; o.x = pk_bf16(s[0 * 33], s[1 * 33]); o.y = pk_bf16(s[2 * 33], s[3 * 33]); o.z = pk_bf16(s[4 * 33], s[5 * 33]); o.w = pk_bf16(s[6 * 33], s[7 * 33]);
        if (n0 + n < len) *(u32x4*)(WT + (size_t)(dst0 + dstride * (n0 + n)) * ldwt + k0 + 8 * c) = o; }
    asm volatile("s_waitcnt lgkmcnt(0)" ::: "memory");
}

constexpr int KPB = 144;
constexpr int TILE_B = 64 * KPB;
constexpr int AL_K = 0, AL_V = 2 * TILE_B, AL_CS = 4 * TILE_B, AL_MISC = AL_CS + 512, AL_PSL = AL_MISC + 512, PSL_P = 65, AL_SM = AL_PSL + 257 * PSL_P * 4, AL_LIST = AL_SM + 64 * 8 * 4, AL_TMP = AL_LIST + 1024 + 64, AL_END = AL_TMP + 2 * 8 * 17 * 32 * 4;

#define MFMA32(a, b, c) __builtin_amdgcn_mfma_f32_32x32x16_bf16((a), (b), (c), 0, 0, 0)

DI void tile_gload(u32x4& kr, u32x4& vr, const bf16_t* kbase, size_t kpitch, const bf16_t* vbase, size_t vpitch, int tid) {
    const int row = tid >> 3, ch = tid & 7;
    kr = *(const u32x4*)(kbase + (size_t)row * kpitch + ch * 8);
    vr = *(const u32x4*)(vbase + (size_t)row * vpitch + ch * 8);
}
DI void tile_lstore(lptr kb, lptr vb, const u32x4& kr, const u32x4& vr, int tid) {
    const int row = tid >> 3, ch = tid & 7;
    *(LAS u32x4*)(kb + row * KPB + ch * 16) = kr; *(LAS u32x4*)(vb + row * KPB + ch * 16) = vr;
}
DI void qk_acc(lptr Kt, const bf16x8 (&qf)[4], f32x16& s0, f32x16& s1, int lane) {
    const int i = lane & 31, hi = lane >> 5;
    const int krow = (i & 19) | ((i & 4) << 1) | ((i & 8) >> 1);
    lptr kp = Kt + krow * KPB + hi * 16;
    bf16x8 a0[4], a1[4];
#pragma unroll
    for (int d0 = 0; d0 < 4; ++d0) { a0[d0] = *(LAS bf16x8*)(kp + d0 * 32); a1[d0] = *(LAS bf16x8*)(kp + 32 * KPB + d0 * 32); }
    __builtin_amdgcn_s_setprio(1);
#pragma unroll
    for (int d0 = 0; d0 < 4; ++d0) { s0 = MFMA32(a0[d0], qf[d0], s0); s1 = MFMA32(a1[d0], qf[d0], s1); }
    __builtin_amdgcn_s_setprio(0);
}
DI bf16x8 pack8(const f32x16& p, int base) {
    u32x4 w; w.x = pk_bf16(p[base + 0], p[base + 1]); w.y = pk_bf16(p[base + 2], p[base + 3]); w.z = pk_bf16(p[base + 4], p[base + 5]); w.w = pk_bf16(p[base + 6], p[base + 7]);
    return __builtin_bit_cast(bf16x8, w);
}
DI void pv_tile(lptr Vt, const f32x16& p0, const f32x16& p1, f32x16& o0, f32x16& o1, int lane) {
    const int i = lane & 31, hi = lane >> 5;
    lptr vp = Vt + i * KPB + hi * 16;
    {
        const bf16x8 pf = pack8(p0, 0); const bf16x8 v0 = *(LAS bf16x8*)(vp + 0), v1 = *(LAS bf16x8*)(vp + 32 * KPB + 0);
        o0 = MFMA32(v0, pf, o0); o1 = MFMA32(v1, pf, o1);
    }
    {
        const bf16x8 pf = pack8(p0, 8); const bf16x8 v0 = *(LAS bf16x8*)(vp + 32), v1 = *(LAS bf16x8*)(vp + 32 * KPB + 32);
        o0 = MFMA32(v0, pf, o0); o1 = MFMA32(v1, pf, o1);
    }
    {
        const bf16x8 pf = pack8(p1, 0); const bf16x8 v0 = *(LAS bf16x8*)(vp + 64), v1 = *(LAS bf16x8*)(vp + 32 * KPB + 64);
        o0 = MFMA32(v0, pf, o0); o1 = MFMA32(v1, pf, o1);
    }
    {
        const bf16x8 pf = pack8(p1, 8); const bf16x8 v0 = *(LAS bf16x8*)(vp + 96), v1 = *(LAS bf16x8*)(vp + 32 * KPB + 96);
        o0 = MFMA32(v0, pf, o0); o1 = MFMA32(v1, pf, o1);
    }
}
struct TP { float fb, sl; int lim, lim2; bool sel; const LAS float* cs; };
struct RowState { float mref, l; bool seen; };
template <int MODE>
DI void bias_init(f32x16& s0, f32x16& s1, const TP& tp, float fbm, int hi) {
#pragma unroll
    for (int r = 0; r < 16; ++r) {
        const int kvc = 16 * (r >> 3) + (r & 7);
        if (MODE == 0) { s0[r] = __builtin_fmaf(-L2E, tp.cs[kvc + 8 * hi], fbm); s1[r] = __builtin_fmaf(-L2E, tp.cs[kvc + 32 + 8 * hi], fbm); }
        else { s0[r] = __builtin_fmaf(tp.sl, (float)kvc, fbm); s1[r] = __builtin_fmaf(tp.sl, (float)(kvc + 32), fbm); }
    }
}
DI float max3_asm(float a, float b, float c) { float r; asm("v_max3_f32 %0, %1, %2, %3" : "=v"(r) : "v"(a), "v"(b), "v"(c)); return r; }
template <bool MASK>
DI float mask_rowmax(f32x16& s0, f32x16& s1, const TP& tp) {
    if (MASK) {
#pragma unroll
        for (int r = 0; r < 16; ++r) {
            const int kvc = 16 * (r >> 3) + (r & 7);
            const bool v0 = tp.sel && (kvc <= tp.lim) && (kvc > tp.lim2), v1 = tp.sel && (kvc + 32 <= tp.lim) && (kvc + 32 > tp.lim2);
            s0[r] = v0 ? s0[r] : -1e30f; s1[r] = v1 ? s1[r] : -1e30f;
        }
    }
    const float seed = __builtin_fminf(s0[15], s1[15]);
    float ma = seed, mb = seed;
#pragma unroll
    for (int r = 0; r < 16; r += 2) { ma = max3_asm(ma, s0[r], s1[r]); mb = max3_asm(mb, s0[r + 1], s1[r + 1]); }
    const float mx = fmaxf(ma, mb);
    return fmaxf(mx, __shfl_xor(mx, 32));
}
template <int MODE, bool MASK, bool WITH_O>
DI void attn_tile_t(lptr Kt, lptr Vt, const bf16x8 (&qf)[4], f32x16& o0, f32x16& o1, RowState& rs, const TP& tp, int lane) {
    const int hi = lane >> 5;
    f32x16 s0, s1;
    bias_init<MODE>(s0, s1, tp, tp.fb - rs.mref, hi);
    qk_acc(Kt, qf, s0, s1, lane);
    const float mx = mask_rowmax<MASK>(s0, s1, tp);
    const bool was = rs.seen; rs.seen = was || (mx > -1e29f);
    const bool trig = (mx > 8.f) || (!was && mx > -1e29f && mx < -8.f);
    if (__builtin_expect(__any(trig), 0)) {
        asm volatile("" ::: "memory");
        const float d = trig ? mx : 0.f; rs.mref += d;
        const float al = was ? exp2_fast(-d) : 1.f; rs.l *= al;
        if (WITH_O) { o0 = o0 * al; o1 = o1 * al; }
#pragma unroll
        for (int r = 0; r < 16; ++r) { s0[r] -= d; s1[r] -= d; }
    }
    if (!WITH_O) {
        float sum = 0.f;
#pragma unroll
        for (int r = 0; r < 16; ++r) { s0[r] = exp2_fast(s0[r]); s1[r] = exp2_fast(s1[r]); sum += s0[r] + s1[r]; }
        rs.l += sum;
    } else {
        const int i = lane & 31;
        lptr vp = Vt + i * KPB + hi * 16;
        float sum = 0.f;
#define PV_STEP(S, BASE, JOFF) { \
            const bf16x8 v0 = *(LAS bf16x8*)(vp + (JOFF)), v1 = *(LAS bf16x8*)(vp + 32 * KPB + (JOFF)); \
            _Pragma("unroll") for (int e = 0; e < 8; ++e) { S[(BASE) + e] = exp2_fast(S[(BASE) + e]); sum += S[(BASE) + e]; } \
            const bf16x8 pf = pack8(S, (BASE)); \
            o0 = MFMA32(v0, pf, o0); o1 = MFMA32(v1, pf, o1); \
            __builtin_amdgcn_sched_barrier(0); }
        PV_STEP(s0, 0, 0) PV_STEP(s0, 8, 32) PV_STEP(s1, 0, 64) PV_STEP(s1, 8, 96)
#undef PV_STEP
        rs.l += sum;
    }
}
template <int MODE>
DI void attn_tile(lptr Kt, lptr Vt, const bf16x8 (&qf)[4], f32x16& o0, f32x16& o1, RowState& rs, const TP& tp, bool need_mask, int lane) {
    if (need_mask) attn_tile_t<MODE, true, true>(Kt, Vt, qf, o0, o1, rs, tp, lane);
    else attn_tile_t<MODE, false, true>(Kt, Vt, qf, o0, o1, rs, tp, lane);
}
DI void load_q(bf16x8 (&qf)[4], const bf16_t* qrow, int hi) {
#pragma unroll
    for (int d0 = 0; d0 < 4; ++d0) qf[d0] = *(const bf16x8*)(qrow + d0 * 16 + hi * 8);
}

#define ATT_LOOP_BEGIN(NT, HASCS, KPTR_EXPR, VPTR_EXPR, CS_EXPR) \
  { u32x4 kr_, vr_; float csr_ = 0.f; \
    { const int jt = 0; (void)jt; tile_gload(kr_, vr_, (KPTR_EXPR), kpitch_, (VPTR_EXPR), vpitch_, tid); if (HASCS && tid < 64) csr_ = (CS_EXPR)[tid]; } \
    tile_lstore(L + AL_K, L + AL_V, kr_, vr_, tid); if (HASCS && tid < 64) ((LAS float*)(L + AL_CS))[tid] = csr_; \
    __syncthreads(); \
    for (int jt_ = 0; jt_ < (NT); ++jt_) { const int cur_ = jt_ & 1; \
      if (jt_ + 1 < (NT)) { const int jt = jt_ + 1; (void)jt; tile_gload(kr_, vr_, (KPTR_EXPR), kpitch_, (VPTR_EXPR), vpitch_, tid); if (HASCS && tid < 64) csr_ = (CS_EXPR)[tid]; } \
      { const int jt = jt_; (void)jt; lptr Kt = L + AL_K + cur_ * TILE_B; lptr Vt = L + AL_V + cur_ * TILE_B; const LAS float* csb = (const LAS float*)(L + AL_CS) + cur_ * 64; (void)Kt; (void)Vt; (void)csb;
#define ATT_LOOP_END(NT, HASCS) } \
      if (jt_ + 1 < (NT)) { tile_lstore(L + AL_K + (cur_ ^ 1) * TILE_B, L + AL_V + (cur_ ^ 1) * TILE_B, kr_, vr_, tid); if (HASCS && tid < 64) ((LAS float*)(L + AL_CS))[(cur_ ^ 1) * 64 + tid] = csr_; } \
      __syncthreads(); } }

DI void store_o_bf16(bf16_t* orow, const f32x16& o0, const f32x16& o1, float sc, int hi) {
#pragma unroll
    for (int g4 = 0; g4 < 4; ++g4) {
        u32x2 w0, w1;
        w0.x = pk_bf16(o0[4 * g4] * sc, o0[4 * g4 + 1] * sc); w0.y = pk_bf16(o0[4 * g4 + 2] * sc, o0[4 * g4 + 3] * sc);
        w1.x = pk_bf16(o1[4 * g4] * sc, o1[4 * g4 + 1] * sc); w1.y = pk_bf16(o1[4 * g4 + 2] * sc, o1[4 * g4 + 3] * sc);
        *(u32x2*)(orow + 8 * g4 + 4 * hi) = w0; *(u32x2*)(orow + 32 + 8 * g4 + 4 * hi) = w1;
    }
}
DI float sigmoid_f(float x) { return 1.f / (1.f + __expf(-x)); }

DI void fox_unit(const Params& P, lptr L, int u, int tid, int lane, int wid) {
    unsigned char* ws = P.ws;
    const bf16_t* PROJ = (const bf16_t*)(ws + WS_PROJ); const bf16_t* VT = (const bf16_t*)(ws + WS_VT); bf16_t* ATT = (bf16_t*)(ws + WS_U);
    const float* CARR = (const float*)(ws + WS_C); const unsigned* CTL = (const unsigned*)(ws + WS_CTL);
    const int bh = u & 15, b = bh >> 3, h = bh & 7, qt = 63 - (u >> 4);
    const int i = lane & 31, hi = lane >> 5;
    const int t0 = qt * 256, tq0 = t0 + wid * 32, t = tq0 + i;
    const float* carr = CARR + (size_t)(b * 8 + h) * SEQ;
    volatile LAS int* misc = (volatile LAS int*)(L + AL_MISC);
    if (tid == 0) misc[0] = t0 >> 6;
    __syncthreads();
    {
        const float qn2 = __uint_as_float(CTL[CW_NRM + b * 16 + h]), kn2 = __uint_as_float(CTL[CW_NRM + b * 16 + 8 + h]);
        const float bnd = 2.f * sqrtf(qn2 * kn2) * (1.01f / L2E) + 0.5f;
        const int ntl = t0 >> 6;
        if (tid < ntl) { if (carr[t0] - carr[64 * tid + 63] + bnd >= -30.f)     __hip_atomic_fetch_min((LAS int*)(L + AL_MISC), tid, __ATOMIC_RELAXED, __HIP_MEMORY_SCOPE_WORKGROUP); }
    }
    __syncthreads();
    const int jlo = misc[0], jhi = 4 * qt + 3, NT = jhi - jlo + 1;
    const int jw_hi = (tq0 + 31) >> 6;
    bf16x8 qf[4]; load_q(qf, PROJ + (size_t)(b * SEQ + t) * PROJ_LD + h * 64, hi);
    const float ct = carr[t] * L2E;
    f32x16 o0, o1;
#pragma unroll
    for (int r = 0; r < 16; ++r) { o0[r] = 0.f; o1[r] = 0.f; }
    RowState rs; rs.mref = 0.f; rs.l = 0.f; rs.seen = false;
    const bf16_t* kb_ = PROJ + (size_t)(b * SEQ) * PROJ_LD + 512 + h * 64; const size_t kpitch_ = PROJ_LD;
    const bf16_t* vb_ = VT + (size_t)((b * 12 + h) * 64) * VTP; const size_t vpitch_ = VTP;
    ATT_LOOP_BEGIN(NT, true, kb_ + (size_t)((jlo + jt) * 64) * PROJ_LD, vb_ + (size_t)(jlo + jt) * 64, carr + (jlo + jt) * 64)
        const int j = jlo + jt, kv0 = j * 64;
        if (j <= jw_hi) {
            TP tp; tp.fb = ct; tp.sl = 0.f; tp.lim = t - kv0 - 8 * hi; tp.lim2 = -(1 << 30); tp.sel = true; tp.cs = csb;
            attn_tile<0>(Kt, Vt, qf, o0, o1, rs, tp, kv0 + 63 > tq0, lane);
        }
    ATT_LOOP_END(NT, true)
    float l = rs.l; l += __shfl_xor(l, 32);
    const float inv = 1.f / fmaxf(l, 1e-30f);
    store_o_bf16(ATT + (size_t)(b * SEQ + t) * DM + h * 64, o0, o1, inv, hi);
}

DI void cmpwin_unit(const Params& P, lptr L, int u, int tid, int lane, int wid) {
    unsigned char* ws = P.ws;
    const bf16_t* PROJ = (const bf16_t*)(ws + WS_PROJ); const bf16_t* VT = (const bf16_t*)(ws + WS_VT);
    const bf16_t* KC = (const bf16_t*)(ws + WS_KC); const bf16_t* VCT = (const bf16_t*)(ws + WS_VCT);
    float* PART = (float*)(ws + WS_PART);
    const int bg = u & 3, b = bg >> 1, g = bg & 1, qb = 255 - (u >> 2);
    const int r4 = wid & 3, qs = wid >> 2, i = lane & 31, hi = lane >> 5;
    const int head = g * 4 + r4, tq0 = qb * 64 + qs * 32, t = tq0 + i, ql = qs * 32 + i;
    const size_t row = (size_t)b * SEQ + t;
    const float slope = exp2f(-(float)(head + 1)), sl = slope * L2E;
    bf16x8 qf[4]; load_q(qf, PROJ + row * PROJ_LD + 1024 + head * 64, hi);
    const bf16_t* grow = PROJ + row * PROJ_LD + 1792 + head * 3;
    const float gc = sigmoid_f(bf2f(grow[0])), gwn = sigmoid_f(bf2f(grow[2]));
    LAS float* psl = (LAS float*)(L + AL_PSL);
    const int nlim = (t >= 31) ? min((t - 31) >> 4, 1022) : -1;
    const int NTC = ((4 * qb + 2) >> 6) + 1;
    for (int rp_ = 0; rp_ < ((PROBE_SUB & 1) ? 2 : 1); ++rp_)
    {
        const bf16_t* kb_ = KC + (size_t)((b * 2 + g) * 1024) * 64; const size_t kpitch_ = 64;
        const bf16_t* vb_ = VCT + (size_t)((b * 2 + g) * 64) * 1024; const size_t vpitch_ = 1024;
        const int nfull = (tq0 - 31) >> 4;
        RowState rs; rs.mref = 0.f; rs.l = 0.f; rs.seen = false;
        f32x16 od0, od1;
        ATT_LOOP_BEGIN(NTC, false, kb_ + (size_t)(jt * 64) * 64, vb_ + (size_t)jt * 64, (const float*)nullptr)
            const int n0 = jt * 64;
            TP tp; tp.cs = nullptr; tp.sl = 16.f * sl; tp.fb = sl * (float)(16 * (n0 + 8 * hi) + 31 - t); tp.lim = nlim - n0 - 8 * hi; tp.lim2 = -(1 << 30); tp.sel = true;
            if (n0 + 63 <= nfull) attn_tile_t<1, false, false>(Kt, Vt, qf, od0, od1, rs, tp, lane);
            else attn_tile_t<1, true, false>(Kt, Vt, qf, od0, od1, rs, tp, lane);
        ATT_LOOP_END(NTC, false)
        float l = rs.l; l += __shfl_xor(l, 32);
        const float mfin = (l > 0.f) ? rs.mref + __builtin_amdgcn_logf(l) : 0.f;
        for (int e = tid; e < 257 * PSL_P; e += 512) psl[e] = 0.f;
        __syncthreads();
        f32x16 o0, o1;
#pragma unroll
        for (int r = 0; r < 16; ++r) { o0[r] = 0.f; o1[r] = 0.f; }
        ATT_LOOP_BEGIN(NTC, false, kb_ + (size_t)(jt * 64) * 64, vb_ + (size_t)jt * 64, (const float*)nullptr)
            const int n0 = jt * 64;
            TP tp; tp.cs = nullptr; tp.sl = 16.f * sl; tp.fb = sl * (float)(16 * (n0 + 8 * hi) + 31 - t); tp.lim = nlim - n0 - 8 * hi; tp.lim2 = -(1 << 30); tp.sel = true;
            f32x16 s0, s1;
            bias_init<1>(s0, s1, tp, tp.fb - mfin, hi);
            qk_acc(Kt, qf, s0, s1, lane);
            if (n0 + 63 > nfull) (void)mask_rowmax<true>(s0, s1, tp);
#pragma unroll
            for (int r = 0; r < 16; ++r) { s0[r] = exp2_fast(s0[r]); s1[r] = exp2_fast(s1[r]); }
            {
                if (jt > 0) {
                    const LAS float* tp_ = (const LAS float*)(L + AL_TMP) + (cur_ ^ 1) * (8 * 17 * 32);
                    for (int e = tid; e < 2 * 17 * 32; e += 512) { const int q32 = e & 31, jl = (e >> 5) % 17, qh = e / (17 * 32);
                        const float a = (tp_[((qh * 4 + 0) * 17 + jl) * 32 + q32] + tp_[((qh * 4 + 1) * 17 + jl) * 32 + q32]) + (tp_[((qh * 4 + 2) * 17 + jl) * 32 + q32] + tp_[((qh * 4 + 3) * 17 + jl) * 32 + q32]);
                        psl[((n0 - 64) / 4 + jl) * PSL_P + qh * 32 + q32] += a; }
                }
                LAS float* tw = (LAS float*)(L + AL_TMP) + (cur_ * 8 + wid) * (17 * 32) + i;
                const float c0 = s0[7], c1 = s0[15], c2 = s1[7], c3 = s1[15];
                const float x0 = __shfl_xor(c0, 32), x1 = __shfl_xor(c1, 32), x2 = __shfl_xor(c2, 32), x3 = __shfl_xor(c3, 32);
                const float in0 = hi ? x0 : 0.f, in1 = hi ? x1 : x0, in2 = hi ? x2 : x1, in3 = hi ? x3 : x2;
                const float a0 = (s0[0] + s0[1]) + (s0[2] + s0[3]) + in0, b0 = (s0[4] + s0[5]) + (s0[6] + s0[7]) + s0[3];
                const float a1 = (s0[8] + s0[9]) + (s0[10] + s0[11]) + in1, b1 = (s0[12] + s0[13]) + (s0[14] + s0[15]) + s0[11];
                const float a2 = (s1[0] + s1[1]) + (s1[2] + s1[3]) + in2, b2 = (s1[4] + s1[5]) + (s1[6] + s1[7]) + s1[3];
                const float a3 = (s1[8] + s1[9]) + (s1[10] + s1[11]) + in3, b3 = (s1[12] + s1[13]) + (s1[14] + s1[15]) + s1[11];
                tw[(0 + 2 * hi) * 32] = a0; tw[(1 + 2 * hi) * 32] = b0; tw[(4 + 2 * hi) * 32] = a1; tw[(5 + 2 * hi) * 32] = b1;
                tw[(8 + 2 * hi) * 32] = a2; tw[(9 + 2 * hi) * 32] = b2; tw[(12 + 2 * hi) * 32] = a3; tw[(13 + 2 * hi) * 32] = b3;
                if (hi) tw[16 * 32] = c3;
            }
            pv_tile(Vt, s0, s1, o0, o1, lane);
        ATT_LOOP_END(NTC, false)
        {
            const LAS float* tp_ = (const LAS float*)(L + AL_TMP) + ((NTC - 1) & 1) * (8 * 17 * 32);
            for (int e = tid; e < 2 * 17 * 32; e += 512) { const int q32 = e & 31, jl = (e >> 5) % 17, qh = e / (17 * 32);
                const float a = (tp_[((qh * 4 + 0) * 17 + jl) * 32 + q32] + tp_[((qh * 4 + 1) * 17 + jl) * 32 + q32]) + (tp_[((qh * 4 + 2) * 17 + jl) * 32 + q32] + tp_[((qh * 4 + 3) * 17 + jl) * 32 + q32]);
                psl[((NTC - 1) * 16 + jl) * PSL_P + qh * 32 + q32] += a; }
            __syncthreads();
        }
        float* prow = PART + row * 512 + head * 64;
#pragma unroll
        for (int g4 = 0; g4 < 4; ++g4) {
            *(f32x4*)(prow + 8 * g4 + 4 * hi) = (f32x4){o0[4 * g4] * gc, o0[4 * g4 + 1] * gc, o0[4 * g4 + 2] * gc, o0[4 * g4 + 3] * gc};
            *(f32x4*)(prow + 32 + 8 * g4 + 4 * hi) = (f32x4){o1[4 * g4] * gc, o1[4 * g4 + 1] * gc, o1[4 * g4 + 2] * gc, o1[4 * g4 + 3] * gc};
        }
    }
    for (int rp_ = 0; rp_ < ((PROBE_SUB & 2) ? 2 : 1); ++rp_)
    {
        const int cur = qb;
        const int nforced = cur == 0 ? 1 : (cur == 1 ? 2 : 3);
        const int ncand = max(0, cur - 2), K = min(16, cur + 1) - nforced;
        const unsigned long long lt_mask = (1ull << lane) - 1ull;
        for (int qq = 0; qq < 8; ++qq) {
            const int q = wid * 8 + qq; const int tq = qb * 64 + q;
            unsigned key[4]; bool cand[4], selb[4];
#pragma unroll
            for (int ii = 0; ii < 4; ++ii) { const int j = lane + 64 * ii; key[ii] = __float_as_uint(psl[j * PSL_P + q]);
                cand[ii] = (j >= 1) && (j <= cur - 2); selb[ii] = (j == 0) || (j == cur) || (j == cur - 1); }
            if (K >= ncand) {
#pragma unroll
                for (int ii = 0; ii < 4; ++ii) selb[ii] = selb[ii] || cand[ii];
            } else {
                unsigned tau = 0u;
                for (int bit = 30; bit >= 0; --bit) {
                    const unsigned trial = tau | (1u << bit);
                    int cnt = 0;
#pragma unroll
                    for (int ii = 0; ii < 4; ++ii) cnt += __popcll(__ballot(cand[ii] && key[ii] >= trial));
                    if (cnt == K) { tau = trial - 1u; break; }
                    if (cnt > K) tau = trial;
                }
                int cgt = 0;
#pragma unroll
                for (int ii = 0; ii < 4; ++ii) cgt += __popcll(__ballot(cand[ii] && key[ii] > tau));
                int need = K - cgt;
#pragma unroll
                for (int ii = 0; ii < 4; ++ii) {
                    const bool eq = cand[ii] && key[ii] == tau;
                    const unsigned long long bal = __ballot(eq);
                    const int rank = __popcll(bal & lt_mask);
                    selb[ii] = selb[ii] || (cand[ii] && key[ii] > tau) || (eq && rank < need);
                    need = max(0, need - (int)__popcll(bal));
                }
            }
            LAS unsigned* mrow = (LAS unsigned*)(L + AL_SM) + q * 8; (void)tq;
#pragma unroll
            for (int ii = 0; ii < 4; ++ii) { const unsigned long long bal = __ballot(selb[ii]); if (lane == 0) { mrow[2 * ii] = (unsigned)bal; mrow[2 * ii + 1] = (unsigned)(bal >> 32); } }
        }
    }
    for (int rp_ = 0; rp_ < ((PROBE_SUB & 4) ? 2 : 1); ++rp_)
    {
        f32x16 o0, o1;
#pragma unroll
        for (int r = 0; r < 16; ++r) { o0[r] = 0.f; o1[r] = 0.f; }
        RowState rs; rs.mref = 0.f; rs.l = 0.f; rs.seen = false;
        const int jw0 = max(0, qb - 8), NTW = qb - jw0 + 1;
        const bf16_t* kb_ = PROJ + (size_t)(b * SEQ) * PROJ_LD + 1664 + g * 64; const size_t kpitch_ = PROJ_LD;
        const bf16_t* vb_ = VT + (size_t)((b * 12 + 10 + g) * 64) * VTP; const size_t vpitch_ = VTP;
        ATT_LOOP_BEGIN(NTW, false, kb_ + (size_t)((jw0 + jt) * 64) * PROJ_LD, vb_ + (size_t)(jw0 + jt) * 64, (const float*)nullptr)
            const int kv0 = (jw0 + jt) * 64;
            TP tp; tp.cs = nullptr; tp.sl = sl; tp.fb = sl * (float)(kv0 + 8 * hi - t); tp.lim = t - kv0 - 8 * hi; tp.lim2 = tp.lim - 512; tp.sel = true;
            const bool full = (kv0 + 63 <= tq0) && (tq0 + 31 - kv0 < 512);
            attn_tile<1>(Kt, Vt, qf, o0, o1, rs, tp, !full, lane);
        ATT_LOOP_END(NTW, false)
        float l = rs.l; l += __shfl_xor(l, 32);
        const float sc = gwn / fmaxf(l, 1e-30f);
        float* prow = PART + row * 512 + head * 64;
        if ((PROBE_SUB & 4) && rp_ == 0) continue;
#pragma unroll
        for (int g4 = 0; g4 < 4; ++g4) {
            f32x4 a = *(f32x4*)(prow + 8 * g4 + 4 * hi), c = *(f32x4*)(prow + 32 + 8 * g4 + 4 * hi);
            a = a + (f32x4){o0[4 * g4] * sc, o0[4 * g4 + 1] * sc, o0[4 * g4 + 2] * sc, o0[4 * g4 + 3] * sc};
            c = c + (f32x4){o1[4 * g4] * sc, o1[4 * g4 + 1] * sc, o1[4 * g4 + 2] * sc, o1[4 * g4 + 3] * sc};
            *(f32x4*)(prow + 8 * g4 + 4 * hi) = a; *(f32x4*)(prow + 32 + 8 * g4 + 4 * hi) = c;
        }
    }
}

DI void slc_unit(const Params& P, lptr L, int u, int tid, int lane, int wid) {
    unsigned char* ws = P.ws;
    const bf16_t* PROJ = (const bf16_t*)(ws + WS_PROJ); const bf16_t* VT = (const bf16_t*)(ws + WS_VT);
    const float* PART = (const float*)(ws + WS_PART); bf16_t* ATT = (bf16_t*)(ws + WS_U);
    const int bg = u & 3, b = bg >> 1, g = bg & 1, qb = 255 - (u >> 2);
    const int r4 = wid & 3, qs = wid >> 2, i = lane & 31, hi = lane >> 5;
    const int head = g * 4 + r4, tq0 = qb * 64 + qs * 32, t = tq0 + i, ql = qs * 32 + i;
    const size_t row = (size_t)b * SEQ + t;
    const float slope = exp2f(-(float)(head + 1)), sl = slope * L2E;
    LAS unsigned* sm = (LAS unsigned*)(L + AL_SM);
    LAS unsigned* un = (LAS unsigned*)(L + AL_MISC);
    LAS unsigned char* list = (LAS unsigned char*)(L + AL_LIST);
    if (tid < 16) un[tid] = 0u;
    __syncthreads();
    { const unsigned w = sm[tid]; if (w) __hip_atomic_fetch_or(un + (tid & 7), w, __ATOMIC_RELAXED, __HIP_MEMORY_SCOPE_WORKGROUP); }
    __syncthreads();
    if (tid < 256) {
        const unsigned w = un[tid >> 5];
        if ((w >> (tid & 31)) & 1u) {
            int pos = __popc(w & ((1u << (tid & 31)) - 1u));
            for (int k = 0; k < (tid >> 5); ++k) pos += __popc(un[k]);
            list[pos] = (unsigned char)tid;
        }
    }
    int NTS = 0;
#pragma unroll
    for (int k = 0; k < 8; ++k) NTS += __popc(un[k]);
    __syncthreads();
    bf16x8 qf[4]; load_q(qf, PROJ + row * PROJ_LD + 1024 + head * 64, hi);
    const float gs = sigmoid_f(bf2f(PROJ[row * PROJ_LD + 1792 + head * 3 + 1]));
    f32x16 o0, o1;
#pragma unroll
    for (int r = 0; r < 16; ++r) { o0[r] = 0.f; o1[r] = 0.f; }
    RowState rs; rs.mref = 0.f; rs.l = 0.f; rs.seen = false;
    const bf16_t* kb_ = PROJ + (size_t)(b * SEQ) * PROJ_LD + 1536 + g * 64; const size_t kpitch_ = PROJ_LD;
    const bf16_t* vb_ = VT + (size_t)((b * 12 + 8 + g) * 64) * VTP; const size_t vpitch_ = VTP;
    ATT_LOOP_BEGIN(NTS, false, kb_ + (size_t)((int)list[jt] * 64) * PROJ_LD, vb_ + (size_t)((int)list[jt]) * 64, (const float*)nullptr)
        const int j = (int)list[jt], kv0 = j * 64;
        const bool sel = (sm[ql * 8 + (j >> 5)] >> (j & 31)) & 1u;
        if (__any(sel)) {
            TP tp; tp.cs = nullptr; tp.sl = sl; tp.fb = sl * (float)(kv0 + 8 * hi - t); tp.lim = t - kv0 - 8 * hi; tp.lim2 = -(1 << 30); tp.sel = sel;
            attn_tile<1>(Kt, Vt, qf, o0, o1, rs, tp, true, lane);
        }
    ATT_LOOP_END(NTS, false)
    float l = rs.l; l += __shfl_xor(l, 32);
    const float sc = gs / fmaxf(l, 1e-30f);
    const float* prow = PART + row * 512 + head * 64;
    bf16_t* orow = ATT + row * DM + 512 + head * 64;
#pragma unroll
    for (int g4 = 0; g4 < 4; ++g4) {
        const f32x4 a = *(const f32x4*)(prow + 8 * g4 + 4 * hi), c = *(const f32x4*)(prow + 32 + 8 * g4 + 4 * hi);
        u32x2 w0, w1;
        w0.x = pk_bf16(a[0] + o0[4 * g4] * sc, a[1] + o0[4 * g4 + 1] * sc); w0.y = pk_bf16(a[2] + o0[4 * g4 + 2] * sc, a[3] + o0[4 * g4 + 3] * sc);
        w1.x = pk_bf16(c[0] + o1[4 * g4] * sc, c[1] + o1[4 * g4 + 1] * sc); w1.y = pk_bf16(c[2] + o1[4 * g4 + 2] * sc, c[3] + o1[4 * g4 + 3] * sc);
        *(u32x2*)(orow + 8 * g4 + 4 * hi) = w0; *(u32x2*)(orow + 32 + 8 * g4 + 4 * hi) = w1;
    }
}

template <bool IN16, bool OUT16, int NB>
DI void rowwise_phase(const void* hin, const bf16_t* mo, const float* gA, void* hout, const float* gB, bf16_t* uout, float* rstd_out, int gw, int NGW, int lane) {
    for (int row0 = NB * gw; row0 < MT; row0 += NB * NGW) {
        u32x2 mw[NB][4]; u32x2 hw[NB][4]; f32x4 hx[NB][4];
#pragma unroll
        for (int b = 0; b < NB; ++b) {
            const int row = row0 + b;
#pragma unroll
            for (int jj = 0; jj < 4; ++jj) {
                mw[b][jj] = ((const u32x2*)(mo + (size_t)row * DM) + lane)[64 * jj];
                if (IN16) hw[b][jj] = ((const u32x2*)((const bf16_t*)hin + (size_t)row * DM) + lane)[64 * jj];
                else hx[b][jj] = ((const f32x4*)((const float*)hin + (size_t)row * DM) + lane)[64 * jj];
            }
        }
#pragma unroll
        for (int b = 0; b < NB; ++b) {
            const int row = row0 + b;
            f32x4 mv[4], hv[4]; float ss = 0.f;
#pragma unroll
            for (int jj = 0; jj < 4; ++jj) { const u32x2 m2 = mw[b][jj]; mv[jj] = (f32x4){bflo(m2.x), bfhi(m2.x), bflo(m2.y), bfhi(m2.y)};
                if (IN16) { const u32x2 h2 = hw[b][jj]; hv[jj] = (f32x4){bflo(h2.x), bfhi(h2.x), bflo(h2.y), bfhi(h2.y)}; } else hv[jj] = hx[b][jj];
                ss += (mv[jj].x * mv[jj].x + mv[jj].y * mv[jj].y) + (mv[jj].z * mv[jj].z + mv[jj].w * mv[jj].w); }
            const float rstd = 1.f / sqrtf(wave_sum(ss) * (1.f / DM) + RMS_EPS);
            float s2 = 0.f;
#pragma unroll
            for (int jj = 0; jj < 4; ++jj) { const f32x4 ga = *((const f32x4*)gA + lane + 64 * jj); hv[jj] = hv[jj] + mv[jj] * rstd * ga;
                if (OUT16) { u32x2 w; w.x = pk_bf16(hv[jj].x, hv[jj].y); w.y = pk_bf16(hv[jj].z, hv[jj].w); ((u32x2*)((bf16_t*)hout + (size_t)row * DM) + lane)[64 * jj] = w; }
                else ((f32x4*)((float*)hout + (size_t)row * DM) + lane)[64 * jj] = hv[jj];
                s2 += (hv[jj].x * hv[jj].x + hv[jj].y * hv[jj].y) + (hv[jj].z * hv[jj].z + hv[jj].w * hv[jj].w); }
            if (rstd_out) { const float rstd2 = 1.f / sqrtf(wave_sum(s2) * (1.f / DM) + RMS_EPS); if (lane == 0) rstd_out[row] = rstd2; }
            if (uout) {
                const float rstd2 = 1.f / sqrtf(wave_sum(s2) * (1.f / DM) + RMS_EPS);
                u32x2* uo = (u32x2*)(uout + (size_t)row * DM) + lane;
#pragma unroll
                for (int jj = 0; jj < 4; ++jj) { const f32x4 gb = *((const f32x4*)gB + lane + 64 * jj); const f32x4 y = hv[jj] * rstd2 * gb;
                    u32x2 w; w.x = pk_bf16(y.x, y.y); w.y = pk_bf16(y.z, y.w); uo[64 * jj] = w; }
            }
        }
    }
}
DI float log_sigmoid_f(float z) { return fminf(z, 0.f) - log1pf(__expf(-fabsf(z))); }

DI void p0_row(const Params& P, int row, const f32x4 (&v)[4], bf16_t* U, float* LOGF, const LAS f32x4* wf, int lane) {
    float ss = 0.f;
#pragma unroll
    for (int jj = 0; jj < 4; ++jj) { ss += (v[jj].x * v[jj].x + v[jj].y * v[jj].y) + (v[jj].z * v[jj].z + v[jj].w * v[jj].w); }
    const float rstd = 1.f / sqrtf(wave_sum(ss) * (1.f / DM) + RMS_EPS);
    u32x2* uo = (u32x2*)(U + (size_t)row * DM) + lane;
    float acc[8];
#pragma unroll
    for (int j = 0; j < 8; ++j) acc[j] = 0.f;
#pragma unroll
    for (int jj = 0; jj < 4; ++jj) { const f32x4 g0 = *((const f32x4*)P.norm_g + lane + 64 * jj); const f32x4 y = v[jj] * rstd * g0;
        u32x2 w; w.x = pk_bf16(y.x, y.y); w.y = pk_bf16(y.z, y.w); uo[64 * jj] = w;
#pragma unroll
        for (int e = 0; e < 4; ++e) { const f32x4 wa = wf[((jj * 4 + e) * 2 + 0) * 64 + lane], wb = wf[((jj * 4 + e) * 2 + 1) * 64 + lane]; const float ye = y[e];
            acc[0] += ye * wa.x; acc[1] += ye * wa.y; acc[2] += ye * wa.z; acc[3] += ye * wa.w; acc[4] += ye * wb.x; acc[5] += ye * wb.y; acc[6] += ye * wb.z; acc[7] += ye * wb.w; } }
    float mine = 0.f;
#pragma unroll
    for (int j = 0; j < 8; ++j) { const float s = wave_sum(acc[j]); if (lane == j) mine = s; }
    if (lane < 8) { const int b = row >> 14, t = row & (SEQ - 1); LOGF[(size_t)(b * 8 + lane) * SEQ + t] = log_sigmoid_f(mine + P.b_f[lane]); }
}

DI bool seg_late(int s) { return s >= 11 && s != 16 && s != 17; }
DI int transposes_total(bool late) { int total = 0; for (int s = 0; s < NSEG; ++s) if (seg_late(s) == late) total += (SEGS[s].K / 64) * ((SEGS[s].len + 31) / 32); return total; }
DI void transpose_by_index(const Params& P, unsigned char* ws, LAS float* scr, int idx, bool late, int lane) {
    int rem = idx, s = 0;
    for (; s < NSEG; ++s) { if (seg_late(s) != late) continue; const int n = (SEGS[s].K / 64) * ((SEGS[s].len + 31) / 32); if (rem < n) break; rem -= n; }
    const Seg sg = SEGS[s]; const int nnb = (sg.len + 31) / 32;
    const float* W = (sg.inp == 2 ? P.w_in : sg.inp == 7 ? P.w_out : sg.inp == 8 ? P.pool_w : sg.inp == 5 ? P.cmp_w1 : sg.inp == 10 ? P.w_gate : sg.inp == 11 ? P.w_up : P.w_down) + sg.srcoff;
    transpose_item(W, sg.ldw, sg.src0, sg.len, (bf16_t*)(ws + (size_t)sg.dstoff_kb * 1024), sg.ldwt, sg.dst0, sg.dstride, sg.scoff >= 0 ? P.pool_scale + sg.scoff : (const float*)nullptr, sg.gkoff >= 0 ? P.norm_g + sg.gkoff : (const float*)nullptr, scr, rem / nnb, rem % nnb, lane);
}

#define XB_TMO      128
#define XB_XCNT(j)  (256  + 64 * (j))
#define XB_XSUB(j)  (1280 + 64 * (j))
#define XB_XGEN(j)  (2304 + 64 * (j))
#define XB_TOP      3328
#define XB_TOPGEN   3392
#define XCD_BAR_WORDS 3456
#define XB_SPIN_CAP (1u << 18)

__device__ __forceinline__ unsigned xb_ld(unsigned* p)              { return __hip_atomic_load(p, __ATOMIC_RELAXED, __HIP_MEMORY_SCOPE_AGENT); }
__device__ __forceinline__ unsigned xb_add(unsigned* p, unsigned v) { return __hip_atomic_fetch_add(p, v, __ATOMIC_RELAXED, __HIP_MEMORY_SCOPE_AGENT); }
__device__ __forceinline__ unsigned xb_xcc_id() { return (unsigned)__builtin_amdgcn_s_getreg((3 << 11) | 20) & 0xFu; }
#define XB_SPIN(cond, bar) do { unsigned _sp = 0; while (cond) { __builtin_amdgcn_s_sleep(1); \
    if ((++_sp & 255u) == 0u) { if (xb_ld(&(bar)[XB_TMO])) break; if (_sp > XB_SPIN_CAP) { atomicAdd(&(bar)[XB_TMO], 1u); break; } } } } while (0)

struct XcdBarrier {
    unsigned* bar; unsigned x;
    volatile LAS unsigned* st;
};

__device__ __forceinline__ XcdBarrier xcd_barrier_post(unsigned* bar, volatile LAS unsigned* st) {
    XcdBarrier b; b.bar = bar; b.x = xb_xcc_id(); b.st = st;
    if (threadIdx.x == 0) (void)xb_add(&bar[XB_XCNT(b.x)], 1u);
    return b;
}
__device__ __forceinline__ void xcd_barrier_complete(unsigned* bar, unsigned x, unsigned& nloc, unsigned& nx) {
    const unsigned G = gridDim.x * gridDim.y * gridDim.z;
    unsigned sum, cnt, mine, sp = 0u;
    for (;;) {
        sum = 0u; cnt = 0u; mine = 0u;
#pragma unroll
        for (unsigned j = 0; j < 16; ++j) { const unsigned c = xb_ld(&bar[XB_XCNT(j)]); sum += c; cnt += (c > 0u) ? 1u : 0u; mine = (j == x) ? c : mine; }
        if (sum == G) break;
        __builtin_amdgcn_s_sleep(1);
        if ((++sp & 255u) == 0u) { if (xb_ld(&bar[XB_TMO])) break; if (sp > XB_SPIN_CAP) { atomicAdd(&bar[XB_TMO], 1u); break; } }
    }
    nloc = mine > 0u ? mine : 1u; nx = cnt > 0u ? cnt : 1u;
}

__device__ __forceinline__ void xcd_barrier(const XcdBarrier& b) {
    asm volatile("s_waitcnt vmcnt(0)" ::: "memory");
    __syncthreads();
    if (threadIdx.x == 0) {
        unsigned* bar = b.bar;
        __builtin_amdgcn_s_waitcnt(0);
        unsigned nloc = b.st[0], nx = b.st[1];
        if (nloc == 0u) { xcd_barrier_complete(bar, b.x, nloc, nx); b.st[0] = nloc; b.st[1] = nx; }
        const unsigned old = xb_add(&bar[XB_XSUB(b.x)], 1u);
        const unsigned gen = old / nloc;
        if (old + 1u == (gen + 1u) * nloc) {
            __builtin_amdgcn_fence(__ATOMIC_RELEASE, "agent");
            asm volatile("s_waitcnt vmcnt(0)" ::: "memory");
            const unsigned og = xb_add(&bar[XB_TOP], 1u);
            const unsigned tg = og / nx;
            if (og + 1u == (tg + 1u) * nx) xb_add(&bar[XB_TOPGEN], 1u);
            else XB_SPIN(xb_ld(&bar[XB_TOPGEN]) == tg, bar);
            __builtin_amdgcn_fence(__ATOMIC_ACQUIRE, "agent");
            xb_add(&bar[XB_XGEN(b.x)], 1u);
            asm volatile("s_waitcnt vmcnt(0)" ::: "memory");
        } else {
            XB_SPIN(xb_ld(&bar[XB_XGEN(b.x)]) == gen, bar);
            __builtin_amdgcn_fence(__ATOMIC_ACQUIRE, "agent");
            asm volatile("s_waitcnt vmcnt(0)" ::: "memory");
        }
    }
    __syncthreads();
}

struct RoundOrder {
    pg8::StaticOrder so; int round;
    __device__ __forceinline__ bool next(int i, pg8::Unit& u) const { return i == 0 ? so.next(round, u) : false; }
    __device__ __forceinline__ void a_ready(const pg8::Unit&) const {}
    __device__ __forceinline__ void done(const pg8::Unit&) const {}
};
template <bool IN16, bool OUT16>
struct EpiResFused {
    static constexpr bool PERM = true, AFTER_DRAIN = true;
    const void* hin; void* hout; const float* gA; float* ssqm; float* ssqh; unsigned* pcnt;
    __device__ __forceinline__ void fused(f32x4 (&acc)[2][2][4][2], const pg8::Unit& u, int wr, int wc, int fr, int fq, PG8_LAS unsigned char* lds, int wid, int lane) const {
        LAS float* red = (LAS float*)lds;
        const int tid = wid * 64 + lane;
#pragma unroll
        for (int ai = 0; ai < 2; ++ai)
#pragma unroll
            for (int m = 0; m < 4; ++m) {
                float s = 0.f;
#pragma unroll
                for (int bj = 0; bj < 2; ++bj)
#pragma unroll
                    for (int n = 0; n < 2; ++n) { const f32x4 x = acc[ai][bj][m][n]; s += (x[0] * x[0] + x[1] * x[1]) + (x[2] * x[2] + x[3] * x[3]); }
                s += __shfl_xor(s, 16); s += __shfl_xor(s, 32);
                if (fq == 0) red[(ai * 128 + wr * 64 + m * 16 + fr) * 4 + wc] = s;
            }
        __syncthreads();
        if (tid < 256) atomicAdd(ssqm + u.pm * 256 + tid, (red[tid * 4] + red[tid * 4 + 1]) + (red[tid * 4 + 2] + red[tid * 4 + 3]));
        asm volatile("s_waitcnt vmcnt(0)" ::: "memory");
        __syncthreads();
        if (tid == 0) { atomicAdd(pcnt + u.pm, 1u); while (__hip_atomic_load(pcnt + u.pm, __ATOMIC_RELAXED, __HIP_MEMORY_SCOPE_AGENT) < 4u) __builtin_amdgcn_s_sleep(2); }
        __syncthreads();
        const int colb = u.pn * 256 + wc * 32 + 8 * fq;
        f32x4 gv[2][2];
#pragma unroll
        for (int bj = 0; bj < 2; ++bj)
#pragma unroll
            for (int n = 0; n < 2; ++n) gv[bj][n] = *(const f32x4*)(gA + colb + bj * 128 + 4 * n);
#pragma unroll
        for (int ai = 0; ai < 2; ++ai)
#pragma unroll
            for (int m = 0; m < 4; ++m) {
                const int rl = ai * 128 + wr * 64 + m * 16 + fr; const size_t row = (size_t)u.pm * 256 + rl;
                const float rm = 1.f / sqrtf(__hip_atomic_load(ssqm + row, __ATOMIC_RELAXED, __HIP_MEMORY_SCOPE_AGENT) * (1.f / DM) + RMS_EPS);
                float sh = 0.f;
#pragma unroll
                for (int bj = 0; bj < 2; ++bj) {
                    const size_t off = row * DM + colb + bj * 128;
                    f32x4 h0, h1;
                    if (IN16) { const u32x4 hw = *(const u32x4*)((const bf16_t*)hin + off); h0 = (f32x4){bflo(hw.x), bfhi(hw.x), bflo(hw.y), bfhi(hw.y)}; h1 = (f32x4){bflo(hw.z), bfhi(hw.z), bflo(hw.w), bfhi(hw.w)}; }
                    else { h0 = *(const f32x4*)((const float*)hin + off); h1 = *(const f32x4*)((const float*)hin + off + 4); }
                    h0 = h0 + acc[ai][bj][m][0] * rm * gv[bj][0]; h1 = h1 + acc[ai][bj][m][1] * rm * gv[bj][1];
                    sh += ((h0[0] * h0[0] + h0[1] * h0[1]) + (h0[2] * h0[2] + h0[3] * h0[3])) + ((h1[0] * h1[0] + h1[1] * h1[1]) + (h1[2] * h1[2] + h1[3] * h1[3]));
                    if (OUT16) { u32x4 w; w.x = pk_bf16(h0[0], h0[1]); w.y = pk_bf16(h0[2], h0[3]); w.z = pk_bf16(h1[0], h1[1]); w.w = pk_bf16(h1[2], h1[3]); *(u32x4*)((bf16_t*)hout + off) = w; }
                    else { *(f32x4*)((float*)hout + off) = h0; *(f32x4*)((float*)hout + off + 4) = h1; }
                }
                if (ssqh) { sh += __shfl_xor(sh, 16); sh += __shfl_xor(sh, 32); if (fq == 0) red[rl * 4 + wc] = sh; }
            }
        if (ssqh) { __syncthreads(); if (tid < 256) atomicAdd(ssqh + u.pm * 256 + tid, (red[tid * 4] + red[tid * 4 + 1]) + (red[tid * 4 + 2] + red[tid * 4 + 3])); }
        __syncthreads();
    }
};
#define FUSED_GEMM(IN16, OUT16, GEMM, HIN, HOUT, GA, SSQM, SSQH, PH) { \
        EpiResFused<IN16, OUT16> E{(HIN), (HOUT), (GA), (SSQM), (SSQH), CTL + CW_PANEL + (PH) * 128}; \
        { RoundOrder S; S.so.init(MT, DM, G, bx); S.round = 0; pg8::gemm_phase<EpiResFused<IN16, OUT16>, RoundOrder, false, true>((PG8_LAS unsigned char*)lds_raw, (GEMM), S, E); } \
        { RoundOrder S; S.so.init(MT, DM, G, bx); S.round = 1; pg8::gemm_phase<EpiResFused<IN16, OUT16>, RoundOrder, false, true>((PG8_LAS unsigned char*)lds_raw, (GEMM), S, E); } }

constexpr int LDS_BYTES = 147456;
static_assert(AL_END <= LDS_BYTES - 64, "attention LDS map");
constexpr int NPH = 17;

__global__ void __launch_bounds__(512) fwd_kernel(Params P) {
    extern __shared__ __attribute__((aligned(16))) unsigned char lds_raw[];
    cg::grid_group grid = cg::this_grid();
    lptr L = (lptr)lds_raw;
    const int tid = threadIdx.x, lane = tid & 63, wid = __builtin_amdgcn_readfirstlane(tid >> 6);
    const int G = gridDim.x, bx = blockIdx.x, gw = bx * 8 + wid, NGW = G * 8;
    unsigned char* ws = P.ws;
    unsigned* CTL = (unsigned*)(ws + WS_CTL);
    bf16_t* U = (bf16_t*)(ws + WS_U);
    bf16_t* MOUT = (bf16_t*)(ws + WS_MOUT);
    float* SSQ = (float*)(ws + WS_SMASK);
    const int lo = P.ph_lo, hi_ = P.ph_hi;
    volatile LAS unsigned* bst_ = (volatile LAS unsigned*)(L + LDS_BYTES - 64);
    if (tid < 2) bst_[tid] = 0u;
    __syncthreads();
    const XcdBarrier xbar_ = xcd_barrier_post(CTL + CW_BAR + P.bar_region * XCD_BAR_WORDS, bst_);
    if (P.ph_hi < 0) grid.sync();
#define IN(k) (lo <= (k) && (k) < hi_)
#define SEAM(k) do { if (IN(k) && IN((k) + 1)) xcd_barrier(xbar_); } while (0)
#ifdef PROBE_DBL
#define REP_BEGIN(k) for (int rep_ = 0; rep_ < (((PROBE_DBL >> (k)) & 1) ? 2 : 1); ++rep_) {
#define REP_END(k) if (((PROBE_DBL >> (k)) & 1) && rep_ == 0) grid.sync(); }
#define REPQ (rep_ * 16)
#else
#define REP_BEGIN(k) {
#define REP_END(k) }
#define REPQ 0
#endif

    if (IN(0)) { REP_BEGIN(0)
        LAS f32x4* wf = (LAS f32x4*)(L + 71680);
        for (int f = tid; f < 2048; f += 512) { const int ln = f & 63, jq = (f >> 6) & 1, e = (f >> 7) & 3, jj = f >> 9, k = 4 * ln + e + 256 * jj;
            wf[f] = *(const f32x4*)(P.w_in + (size_t)k * INC + 1536 + 4 * jq); }
        __syncthreads();
        LAS float* scr = (LAS float*)(L + wid * 8448);
        { const int total = transposes_total(false); for (int idx = gw; idx < total; idx += NGW) transpose_by_index(P, ws, scr, idx, false, lane); }
        float* cbias = (float*)(ws + WS_CBIAS);
        for (int idx = gw; idx < 128; idx += NGW) { const int which = idx >> 6, j = idx & 63; float a = 0.f;
            for (int k = lane; k < 2048; k += 64) a += P.cmp_pe[which * 2048 + k] * P.cmp_w1[(size_t)(which * 2048 + k) * 64 + j];
            a = wave_sum(a); if (lane == 0) cbias[idx] = a; }
        float* LOGF = (float*)(ws + WS_LOGF);
        for (int e = bx * 512 + tid; e < 7 * MT / 4; e += G * 512) ((f32x4*)SSQ)[e] = (f32x4){0.f, 0.f, 0.f, 0.f};
        for (int row0 = 4 * gw; row0 < MT; row0 += 4 * NGW) {
            f32x4 xv[4][4];
#pragma unroll
            for (int b = 0; b < 4; ++b)
#pragma unroll
                for (int jj = 0; jj < 4; ++jj) xv[b][jj] = ((const f32x4*)(P.x + (size_t)(row0 + b) * DM) + lane)[64 * jj];
#pragma unroll
            for (int b = 0; b < 4; ++b) p0_row(P, row0 + b, xv[b], U, LOGF, wf, lane);
        }
        __syncthreads();
    REP_END(0) }
    SEAM(0);
    if (IN(1)) { REP_BEGIN(1)
        pg8::Gemm g{U, (const bf16_t*)(ws + WS_WIN_T), MT, NPROJ, DM, DM, DM, 0, 30}; pg8::StaticOrder S; S.init(MT, NPROJ, G, bx);
        pg8::EpiInProj E{(bf16_t*)(ws + WS_PROJ), (bf16_t*)(ws + WS_VT), (bf16_t*)(ws + WS_CMPIN)};
        pg8::gemm_phase<pg8::EpiInProj, pg8::StaticOrder, true, true>((PG8_LAS unsigned char*)lds_raw, g, S, E);
    REP_END(1) }
    SEAM(1);
    if (IN(2)) {
        pg8::Gemm g{(const bf16_t*)(ws + WS_CMPIN), (const bf16_t*)(ws + WS_W1_T), 8192, 2048, 256, 1024, 2048, 512, 4, 0, 512}; pg8::StaticOrder S; S.init(8192, 2048, G, bx);
        pg8::EpiCompress E{(float*)(ws + WS_HIDP)};
        pg8::gemm_phase<pg8::EpiCompress, pg8::StaticOrder, true, true>((PG8_LAS unsigned char*)lds_raw, g, S, E);
        if (bx < 16) {
            const float* src = (const float*)(ws + WS_LOGF) + (size_t)bx * SEQ + tid * 32; float* dst = (float*)(ws + WS_C) + (size_t)bx * SEQ + tid * 32;
            float v[32];
#pragma unroll
            for (int q = 0; q < 8; ++q) { const f32x4 x4 = *((const f32x4*)src + q); v[4 * q] = x4.x; v[4 * q + 1] = x4.y; v[4 * q + 2] = x4.z; v[4 * q + 3] = x4.w; }
            float run = 0.f;
#pragma unroll
            for (int q = 0; q < 32; ++q) { run += v[q]; v[q] = run; }
            float inc = run;
#pragma unroll
            for (int o = 1; o < 64; o <<= 1) { const float y = __shfl_up(inc, o); if (lane >= o) inc += y; }
            LAS float* wt = (LAS float*)(L + AL_MISC);
            if (lane == 63) wt[wid] = inc;
            __syncthreads();
            float base = inc - run;
            for (int w = 0; w < wid; ++w) base += wt[w];
#pragma unroll
            for (int q = 0; q < 8; ++q) *((f32x4*)dst + q) = (f32x4){v[4 * q] + base, v[4 * q + 1] + base, v[4 * q + 2] + base, v[4 * q + 3] + base};
            __syncthreads();
        }
        const bf16_t* PROJ = (const bf16_t*)(ws + WS_PROJ);
        for (int ch = gw; ch < MT / 16; ch += NGW) {
            float mx = 0.f;
            for (int rr = 0; rr < 16; ++rr) { const int row = ch * 16 + rr;
                const u32x4 a = *(const u32x4*)(PROJ + (size_t)row * PROJ_LD + 16 * lane), c = *(const u32x4*)(PROJ + (size_t)row * PROJ_LD + 16 * lane + 8);
                float ss = 0.f;
#pragma unroll
                for (int e = 0; e < 4; ++e) { const float a0 = bflo(a[e]), a1 = bfhi(a[e]), c0 = bflo(c[e]), c1 = bfhi(c[e]); ss += a0 * a0 + a1 * a1 + c0 * c0 + c1 * c1; }
                ss += __shfl_xor(ss, 1); ss += __shfl_xor(ss, 2);
                mx = fmaxf(mx, ss); }
            if ((lane & 3) == 0) atomicMax(CTL + CW_NRM + ((ch * 16) >> 14) * 16 + (lane >> 2), __float_as_uint(mx));
        }
    }
    SEAM(2);
    if (IN(3)) { REP_BEGIN(3)
        volatile LAS int* qs_ = (volatile LAS int*)(L + AL_MISC + 256);
        bool pp_seen = false;
        for (;;) {
            __syncthreads();
            if (tid == 0) qs_[0] = (int)atomicAdd(CTL + CW_Q3 + REPQ, 1u);
            __syncthreads();
            const int u = qs_[0];
            const int nlate = transposes_total(true), nlate_wg = (nlate + 7) >> 3;
            if (u >= 128 + 2048 + nlate_wg) break;
            if (u >= 128 + 2048) {
                const int idx = (u - (128 + 2048)) * 8 + wid;
                if (idx < nlate) transpose_by_index(P, ws, (LAS float*)(L + 40960 + wid * 8448), idx, true, lane);
                continue;
            }
            if (u < 128) {
                const int which = u >> 6; const float* w2 = P.cmp_w2 + which * 4096;
                float wcol[64];
#pragma unroll
                for (int i2 = 0; i2 < 64; ++i2) wcol[i2] = w2[i2 * 64 + lane];
                const float* HIDP = (const float*)(ws + WS_HIDP); bf16_t* KC = (bf16_t*)(ws + WS_KC); bf16_t* VCT = (bf16_t*)(ws + WS_VCT);
                const float cb = ((const float*)(ws + WS_CBIAS))[which * 64 + lane];
                for (int rr = 0; rr < 8; ++rr) { const int ridx = u * 64 + wid * 8 + rr; const int n = ridx & 1023, bgi = (ridx >> 10) & 3;
                    float hs = cb;
#pragma unroll
                    for (int ks = 0; ks < 8; ++ks) hs += HIDP[((size_t)ks * 8192 + ridx) * 64 + lane];
                    const float hv = pg8::gelu_tanh_f(hs); float o = 0.f;
#pragma unroll
                    for (int i2 = 0; i2 < 64; ++i2) o += __shfl(hv, i2) * wcol[i2];
                    if (n == 1023) o = 0.f;
                    const bf16_t ob = (bf16_t)(pk_bf16(o, 0.f) & 0xffffu);
                    if (which == 0) KC[((size_t)bgi * 1024 + n) * 64 + lane] = ob; else VCT[((size_t)bgi * 64 + lane) * 1024 + n] = ob; }
                asm volatile("s_waitcnt vmcnt(0)" ::: "memory");
                __syncthreads();
                if (tid == 0) { __threadfence(); atomicAdd(CTL + CW_PPDONE + REPQ, 1u); }
            } else {
                const int v = u - 128;
                if (v & 1) fox_unit(P, L, v >> 1, tid, lane, wid);
                else {
                    if (!pp_seen) {
                        if (tid == 0) { while (__hip_atomic_load(CTL + CW_PPDONE + REPQ, __ATOMIC_RELAXED, __HIP_MEMORY_SCOPE_AGENT) < 128u) __builtin_amdgcn_s_sleep(8); }
                        __syncthreads();
                        __builtin_amdgcn_fence(__ATOMIC_ACQUIRE, "agent");
                        pp_seen = true;
                    }
                    cmpwin_unit(P, L, v >> 1, tid, lane, wid);
                    slc_unit(P, L, v >> 1, tid, lane, wid);
                }
            }
        }
    REP_END(3) }
    SEAM(3);
    if (IN(6)) { REP_BEGIN(6)
        pg8::Gemm g{U, (const bf16_t*)(ws + WS_WOUT_T), MT, DM, DM, DM, DM, 0, 30};
        FUSED_GEMM(false, true, g, P.x, ws + WS_H16, P.norm_g + 1 * DM, SSQ + 0 * (size_t)MT, SSQ + 1 * (size_t)MT, 0)
    REP_END(6) }
    SEAM(6);
        if (IN(8)) { REP_BEGIN(8)
            pg8::Gemm g{(const bf16_t*)(ws + WS_H16), (const bf16_t*)(ws + WS_GU_T + 0 * GU_T_STRIDE), MT, 2 * FFH, DM, DM, DM, 0, 30}; pg8::StaticOrder S; S.init(MT, 2 * FFH, G, bx);
            pg8::EpiSwiGLU E{(bf16_t*)(ws + WS_HID), SSQ + 1 * (size_t)MT};
            pg8::gemm_phase<pg8::EpiSwiGLU, pg8::StaticOrder, true, true>((PG8_LAS unsigned char*)lds_raw, g, S, E);
        REP_END(8) }
        SEAM(8);
        if (IN(9)) { REP_BEGIN(9)
            pg8::Gemm g{(const bf16_t*)(ws + WS_HID), (const bf16_t*)(ws + WS_DN_T + 0 * DN_T_STRIDE), MT, DM, FFH, FFH, FFH, 0, 30};
            FUSED_GEMM(true, true, g, ws + WS_H16, ws + WS_H16, P.norm_g + 3 * DM, SSQ + 2 * (size_t)MT, SSQ + 3 * (size_t)MT, 1)
        REP_END(9) }
        SEAM(9);
            if (IN(11)) { REP_BEGIN(11)
                bf16_t* POOLED = (bf16_t*)(ws + WS_POOLED); const bf16_t* H16 = (const bf16_t*)(ws + WS_H16);
                for (int item = bx * 512 + tid; item < 131072; item += G * 512) {
                    const int c0 = (item & 127) * 8, run = item >> 7, row0 = run * 32, t0 = row0 & (SEQ - 1), w = 2 << (c0 >> 8);
                    float sum[8];
#pragma unroll
                    for (int e = 0; e < 8; ++e) sum[e] = 0.f;
                    for (int i2 = 1; i2 < w; ++i2) if (t0 - i2 >= 0) { const u32x4 a = *(const u32x4*)(H16 + (size_t)(row0 - i2) * DM + c0); const float r = 1.f / sqrtf(SSQ[3 * (size_t)MT + row0 - i2] * (1.f / DM) + RMS_EPS);
#pragma unroll
                        for (int e = 0; e < 4; ++e) { sum[2 * e] += bflo(a[e]) * r; sum[2 * e + 1] += bfhi(a[e]) * r; } }
                    for (int tb = 0; tb < 32; tb += 8) {
                        u32x4 cn[8], co[8]; float rn[8], ro[8];
#pragma unroll
                        for (int k = 0; k < 8; ++k) { const int tt = tb + k, t = t0 + tt; const bool old = (tt > 0 && t - w >= 0);
                            cn[k] = *(const u32x4*)(H16 + (size_t)(row0 + tt) * DM + c0); rn[k] = 1.f / sqrtf(SSQ[3 * (size_t)MT + row0 + tt] * (1.f / DM) + RMS_EPS);
                            co[k] = old ? *(const u32x4*)(H16 + (size_t)(row0 + tt - w) * DM + c0) : (u32x4){0u, 0u, 0u, 0u}; ro[k] = old ? 1.f / sqrtf(SSQ[3 * (size_t)MT + row0 + tt - w] * (1.f / DM) + RMS_EPS) : 0.f; }
#pragma unroll
                        for (int k = 0; k < 8; ++k) { const int tt = tb + k, t = t0 + tt;
                            const float rc = 1.f / (float)min(t + 1, w); u32x4 o;
#pragma unroll
                            for (int e = 0; e < 4; ++e) { const float x0 = bflo(cn[k][e]) * rn[k], x1 = bfhi(cn[k][e]) * rn[k];
                                sum[2 * e] += x0 - bflo(co[k][e]) * ro[k]; sum[2 * e + 1] += x1 - bfhi(co[k][e]) * ro[k];
                                o[e] = pk_bf16(sum[2 * e] * rc - x0, sum[2 * e + 1] * rc - x1); }
                            *(u32x4*)(POOLED + (size_t)(row0 + tt) * DM + c0) = o; }
                    }
                }
            REP_END(11) }
            SEAM(11);
            if (IN(12)) { REP_BEGIN(12)
                pg8::Gemm g{(const bf16_t*)(ws + WS_POOLED), (const bf16_t*)(ws + WS_POOL_T), MT, DM, 256, DM, 256, 512, 30};
                FUSED_GEMM(true, true, g, ws + WS_H16, ws + WS_H16, P.norm_g + 5 * DM, SSQ + 4 * (size_t)MT, SSQ + 5 * (size_t)MT, 2)
            REP_END(12) }
            SEAM(12);
        if (IN(14)) {
            pg8::Gemm g{(const bf16_t*)(ws + WS_H16), (const bf16_t*)(ws + WS_GU_T + 1 * GU_T_STRIDE), MT, 2 * FFH, DM, DM, DM, 0, 30}; pg8::StaticOrder S; S.init(MT, 2 * FFH, G, bx);
            pg8::EpiSwiGLU E{(bf16_t*)(ws + WS_HID), SSQ + 5 * (size_t)MT};
            pg8::gemm_phase<pg8::EpiSwiGLU, pg8::StaticOrder, true, true>((PG8_LAS unsigned char*)lds_raw, g, S, E);
        }
        SEAM(14);
        if (IN(15)) {
            pg8::Gemm g{(const bf16_t*)(ws + WS_HID), (const bf16_t*)(ws + WS_DN_T + 1 * DN_T_STRIDE), MT, DM, FFH, FFH, FFH, 0, 30};
            FUSED_GEMM(true, false, g, ws + WS_H16, P.out, P.norm_g + 7 * DM, SSQ + 6 * (size_t)MT, (float*)nullptr, 3)
        }
#undef IN
#undef SEAM
}

#ifndef N_LAUNCHES
#define N_LAUNCHES 1
#endif
extern "C" void kernel_launch(void* const* d_in, const int* in_sizes, int n_in, void* d_out, int out_size, void* d_ws, size_t ws_size, hipStream_t stream) {
    static int grid = 0;
    if (grid == 0) {
        if (n_in != 13 || in_sizes[0] != MT * DM || out_size != MT * DM || ws_size < WS_END) { fprintf(stderr, "kernel_launch: unexpected shapes / workspace (%d inputs, ws %zu)\n", n_in, ws_size); grid = -1; return; }
        int dev = 0, cus = 0, per_cu = 0;
        hipGetDevice(&dev); hipDeviceGetAttribute(&cus, hipDeviceAttributeMultiprocessorCount, dev);
        if (hipFuncSetAttribute((const void*)fwd_kernel, hipFuncAttributeMaxDynamicSharedMemorySize, LDS_BYTES) != hipSuccess) { fprintf(stderr, "kernel_launch: hipFuncSetAttribute failed\n"); grid = -1; return; }
        if (hipOccupancyMaxActiveBlocksPerMultiprocessor(&per_cu, (const void*)fwd_kernel, 512, LDS_BYTES) != hipSuccess || per_cu < 1) { fprintf(stderr, "kernel_launch: occupancy query says %d\n", per_cu); per_cu = 1; }
        (void)hipGetLastError();
        grid = cus * 1;
        if (grid != 256) { fprintf(stderr, "kernel_launch: built for a 256-CU device (one 256x256 GEMM unit per workgroup per round); got %d\n", grid); grid = -1; return; }
    }
    if (grid < 0) return;
    hipMemsetAsync((char*)d_ws + WS_CTL, 0, CTL_BYTES, stream);
    Params p{};
    p.x = (const float*)d_in[0]; p.norm_g = (const float*)d_in[1]; p.w_in = (const float*)d_in[2]; p.b_f = (const float*)d_in[3]; p.cmp_pe = (const float*)d_in[4];
    p.cmp_w1 = (const float*)d_in[5]; p.cmp_w2 = (const float*)d_in[6]; p.w_out = (const float*)d_in[7]; p.pool_w = (const float*)d_in[8]; p.pool_scale = (const float*)d_in[9];
    p.w_gate = (const float*)d_in[10]; p.w_up = (const float*)d_in[11]; p.w_down = (const float*)d_in[12];
    p.out = (float*)d_out; p.ws = (unsigned char*)d_ws;
#if defined(PROBE_PH)
    { Params pa = p, pb = p; pa.ph_lo = 0; pa.ph_hi = PROBE_PH + 1; pa.bar_region = 0; pb.ph_lo = PROBE_PH; pb.ph_hi = NPH; pb.bar_region = 1;
      void* a1[] = {&pa}; void* a2[] = {&pb};
      hipLaunchCooperativeKernel((const void*)fwd_kernel, dim3(grid), dim3(512), a1, LDS_BYTES, stream);
      hipLaunchCooperativeKernel((const void*)fwd_kernel, dim3(grid), dim3(512), a2, LDS_BYTES, stream); }
#elif N_LAUNCHES == 1
    p.ph_lo = 0; p.ph_hi = NPH;
    void* args[] = {&p};
    hipError_t e = hipLaunchCooperativeKernel((const void*)fwd_kernel, dim3(grid), dim3(512), args, LDS_BYTES, stream);
    if (e != hipSuccess) fprintf(stderr, "cooperative launch failed: %s (grid %d)\n", hipGetErrorString(e), grid);
#else
    for (int ph = 0; ph < NPH; ++ph) { p.ph_lo = ph; p.ph_hi = ph + 1; hipLaunchKernelGGL(fwd_kernel, dim3(grid), dim3(512), LDS_BYTES, stream, p); }
#endif
}
```
